# Optimizing an MI355X kernel written in HIP

```python
import jax, jax.numpy as jnp
from jax import lax
import numpy as np

D_MODEL = 1024
BATCH = 16
SEQ = 4096
DEPTH = 1
DEC_BATCH = 2
DEC_SEQ = 16384
PAST_LEN = 128

HEAD_DIM = 64
A_Q_HEADS = 8
A_KV_HEADS = 2
A_WINDOW = 128
B_GROUPS = ((128, 1), (512, 4), (2048, 16))
B_HEADS_PER_GROUP = 4
B_HEADS = B_HEADS_PER_GROUP * len(B_GROUPS)
D_FF = ((8 * D_MODEL + 3 * 256 - 1) // (3 * 256)) * 256
ROPE_THETA = 10000.0
EPS = 1e-6
NEG_INF = -1e30

A_Q_W = A_Q_HEADS * HEAD_DIM
A_KV_W = A_KV_HEADS * HEAD_DIM
B_W = B_HEADS * HEAD_DIM
B_OUT_W = B_HEADS_PER_GROUP * HEAD_DIM
GATE_W = 2 * D_MODEL
IN_SPLITS = [A_Q_W, A_Q_W + A_KV_W, A_Q_W + 2 * A_KV_W,
             A_Q_W + 2 * A_KV_W + B_W, A_Q_W + 2 * A_KV_W + 2 * B_W,
             A_Q_W + 2 * A_KV_W + 3 * B_W]
IN_WIDTH = A_Q_W + 2 * A_KV_W + 3 * B_W + GATE_W

kernel_name = "gated_window_dilated_encoder"


def rms_norm(x, g):
    xf = x.astype(jnp.float32)
    y = xf * lax.rsqrt(jnp.mean(xf * xf, axis=-1, keepdims=True) + EPS) * g.astype(jnp.float32)
    return y.astype(x.dtype)


def rope_tables(seq_len):
    inv_freq = ROPE_THETA ** (-jnp.arange(0, HEAD_DIM, 2, dtype=jnp.float32) / HEAD_DIM)
    ang = jnp.arange(seq_len, dtype=jnp.float32)[:, None] * inv_freq[None, :]
    ang = jnp.concatenate([ang, ang], axis=-1)
    return jnp.cos(ang), jnp.sin(ang)


def apply_rope(t, cos, sin):
    tf = t.astype(jnp.float32)
    half = HEAD_DIM // 2
    rot = jnp.concatenate([-tf[..., half:], tf[..., :half]], axis=-1)
    return (tf * cos[None, :, None, :] + rot * sin[None, :, None, :]).astype(t.dtype)


def banded_attention(q, k, v, window, sink=None):
    n, L, hq, hd = q.shape
    hkv = k.shape[2]
    g = hq // hkv
    blk = window
    nblk = -(-L // blk)
    lp = nblk * blk
    q = jnp.pad(q, ((0, 0), (0, lp - L), (0, 0), (0, 0)))
    pad_kv = ((0, 0), (blk, lp - L + blk), (0, 0), (0, 0))
    kb = jnp.pad(k, pad_kv).reshape(n, nblk + 2, blk, hkv, hd)
    vb = jnp.pad(v, pad_kv).reshape(n, nblk + 2, blk, hkv, hd)
    kn = jnp.concatenate([kb[:, :-2], kb[:, 1:-1], kb[:, 2:]], axis=2)
    vn = jnp.concatenate([vb[:, :-2], vb[:, 1:-1], vb[:, 2:]], axis=2)
    qb = q.reshape(n, nblk, blk, hkv, g, hd)
    s = jnp.einsum('nbqhgd,nbkhd->nbhgqk', qb.astype(jnp.float32), kn.astype(jnp.float32)) * (hd ** -0.5)
    qpos = jnp.arange(nblk)[:, None] * blk + jnp.arange(blk)[None, :]
    kpos = (jnp.arange(nblk)[:, None] - 1) * blk + jnp.arange(3 * blk)[None, :]
    mask = ((jnp.abs(qpos[:, :, None] - kpos[:, None, :]) <= window)
            & (kpos[:, None, :] >= 0) & (kpos[:, None, :] < L))
    s = jnp.where(mask[None, :, None, None], s, NEG_INF)
    m = s.max(-1)
    if sink is not None:
        sk = sink.astype(jnp.float32).reshape(1, 1, hkv, g, 1)
        m = jnp.maximum(m, sk)
    p = jnp.exp(s - m[..., None])
    den = p.sum(-1)
    if sink is not None:
        den = den + jnp.exp(sk - m)
    o = jnp.einsum('nbhgqk,nbkhd->nbqhgd', p, vn.astype(jnp.float32))
    o = o / jnp.transpose(den, (0, 1, 4, 2, 3))[..., None]
    lse = jnp.transpose(m + jnp.log(den), (0, 1, 4, 2, 3)).reshape(n, lp, hq)[:, :L]
    o = o.reshape(n, lp, hq, hd)[:, :L]
    return o.astype(v.dtype), lse


def dilated_attention(q, k, v):
    B, S = q.shape[0], q.shape[1]
    hpg = B_HEADS_PER_GROUP
    outs, lses = [], []
    for gi, (w, d) in enumerate(B_GROUPS):
        lo, hi = gi * hpg, (gi + 1) * hpg
        m = S // d

        def fold(t):
            return (t[:, :, lo:hi].reshape(B, m, d, hpg, HEAD_DIM)
                    .transpose(0, 2, 1, 3, 4).reshape(B * d, m, hpg, HEAD_DIM))

        o, lse = banded_attention(fold(q), fold(k), fold(v), w // (2 * d))
        outs.append(o.reshape(B, d, m, hpg, HEAD_DIM).transpose(0, 2, 1, 3, 4).reshape(B, S, hpg, HEAD_DIM))
        lses.append(lse.reshape(B, d, m, hpg).transpose(0, 2, 1, 3).reshape(B, S, hpg))
    alpha = jax.nn.softmax(jnp.stack(lses), axis=0)
    o = jnp.einsum('gbsh,gbshd->bshd', alpha, jnp.stack(outs).astype(jnp.float32))
    return o.reshape(B, S, B_OUT_W).astype(q.dtype)


def encoder_layer(x, cos, sin, norm1, w_in, qn_a, kn_a, sink_a, qn_b, kn_b,
                  w_br_a, w_br_b, w_out, norm2, w_gate, w_up, w_down):
    B, S, _ = x.shape
    h = rms_norm(x, norm1)
    proj = h @ w_in
    qa, ka, va, qb, kb, vb, gates = jnp.split(proj, IN_SPLITS, axis=-1)
    qa = apply_rope(rms_norm(qa.reshape(B, S, A_Q_HEADS, HEAD_DIM), qn_a), cos, sin)
    ka = apply_rope(rms_norm(ka.reshape(B, S, A_KV_HEADS, HEAD_DIM), kn_a), cos, sin)
    va = va.reshape(B, S, A_KV_HEADS, HEAD_DIM)
    qb = apply_rope(rms_norm(qb.reshape(B, S, B_HEADS, HEAD_DIM), qn_b), cos, sin)
    kb = apply_rope(rms_norm(kb.reshape(B, S, B_HEADS, HEAD_DIM), kn_b), cos, sin)
    vb = vb.reshape(B, S, B_HEADS, HEAD_DIM)
    oa, _ = banded_attention(qa, ka, va, A_WINDOW, sink_a)
    ob = dilated_attention(qb, kb, vb)
    g_a, g_b = jnp.split(jax.nn.sigmoid(gates), 2, axis=-1)
    mix = g_a * (oa.reshape(B, S, A_Q_W) @ w_br_a) + g_b * (ob @ w_br_b)
    x = x + mix @ w_out
    h = rms_norm(x, norm2)
    x = x + (jax.nn.silu(h @ w_gate) * (h @ w_up)) @ w_down
    return x


def setup_inputs(seed: int = 0) -> dict:
    key = jax.random.key(seed)
    ks = jax.random.split(key, 20)
    f32 = jnp.float32

    def nrm(k, shape, scale):
        return jax.random.normal(k, shape, f32) * scale

    return {
        "x_prompt": nrm(ks[0], (BATCH, SEQ, D_MODEL), 1.0),
        "x_sample": nrm(ks[1], (DEC_BATCH, DEC_SEQ, D_MODEL), 1.0),
        "norm1": 1.0 + nrm(ks[2], (DEPTH, D_MODEL), 0.02),
        "w_in": nrm(ks[3], (DEPTH, D_MODEL, IN_WIDTH), D_MODEL ** -0.5),
        "qn_a": 1.0 + nrm(ks[4], (DEPTH, HEAD_DIM), 0.02),
        "kn_a": 1.0 + nrm(ks[5], (DEPTH, HEAD_DIM), 0.02),
        "sink_a": nrm(ks[6], (DEPTH, A_Q_HEADS), 0.5),
        "qn_b": 1.0 + nrm(ks[7], (DEPTH, HEAD_DIM), 0.02),
        "kn_b": 1.0 + nrm(ks[8], (DEPTH, HEAD_DIM), 0.02),
        "w_br_a": nrm(ks[9], (DEPTH, A_Q_W, D_MODEL), A_Q_W ** -0.5),
        "w_br_b": nrm(ks[10], (DEPTH, B_OUT_W, D_MODEL), B_OUT_W ** -0.5),
        "w_out": nrm(ks[11], (DEPTH, D_MODEL, D_MODEL), D_MODEL ** -0.5),
        "norm2": 1.0 + nrm(ks[12], (DEPTH, D_MODEL), 0.02),
        "w_gate": nrm(ks[13], (DEPTH, D_MODEL, D_FF), D_MODEL ** -0.5),
        "w_up": nrm(ks[14], (DEPTH, D_MODEL, D_FF), D_MODEL ** -0.5),
        "w_down": nrm(ks[15], (DEPTH, D_FF, D_MODEL), D_FF ** -0.5),
    }


def run_trunk(x, norm1, w_in, qn_a, kn_a, sink_a, qn_b, kn_b,
              w_br_a, w_br_b, w_out, norm2, w_gate, w_up, w_down):
    cos, sin = rope_tables(x.shape[1])
    for l in range(DEPTH):
        x = encoder_layer(x, cos, sin, norm1[l], w_in[l], qn_a[l], kn_a[l], sink_a[l],
                          qn_b[l], kn_b[l], w_br_a[l], w_br_b[l], w_out[l], norm2[l],
                          w_gate[l], w_up[l], w_down[l])
    return x


def reference(x_prompt, x_sample, norm1, w_in, qn_a, kn_a, sink_a, qn_b, kn_b,
              w_br_a, w_br_b, w_out, norm2, w_gate, w_up, w_down):
    y_prompt = run_trunk(x_prompt, norm1, w_in, qn_a, kn_a, sink_a, qn_b, kn_b,
                         w_br_a, w_br_b, w_out, norm2, w_gate, w_up, w_down)
    y_sample = run_trunk(x_sample, norm1, w_in, qn_a, kn_a, sink_a, qn_b, kn_b,
                         w_br_a, w_br_b, w_out, norm2, w_gate, w_up, w_down)
    return (y_prompt, y_sample)
```

```cpp
#include <hip/hip_runtime.h>
#include <hip/hip_cooperative_groups.h>
#include <cstdio>
#include <cstdint>
#include <cmath>
namespace cg = cooperative_groups;

namespace pg8 {
#define PG8_LAS __attribute__((address_space(3)))
typedef unsigned short bf16_t;
typedef short bf16x8 __attribute__((ext_vector_type(8)));
typedef float f32x4 __attribute__((ext_vector_type(4)));
typedef unsigned u32x4 __attribute__((ext_vector_type(4)));
typedef unsigned u32x2 __attribute__((ext_vector_type(2)));
constexpr int BM = 256, BK = 64, HALF = 128, HTB = HALF * BK * 2  , STAGE_BYTES = 8 * HTB, NXCD = 8, WGM = 8;

__host__ __device__ __forceinline__ int lds_byte(int r, int c) { const int st = (r >> 4) * 2 + (c >> 5), rr = r & 15, cc = c & 31, ob = rr * 64 + cc * 2; return st * 1024 + (ob ^ (((ob >> 9) & 1) << 5)); }
__host__ __device__ __forceinline__ void stage_rc(int b, int& R, int& C) { const int st = b / 1024, sb = b % 1024, swz = sb ^ (((sb >> 9) & 1) << 5); R = (st >> 1) * 16 + swz / 64; C = (st & 1) * 32 + (swz % 64) / 2; }
__host__ __device__ __forceinline__ int perm32(int rho) { const int n = rho >> 4, i = rho & 15; return 8 * (i >> 2) + 4 * n + (i & 3); }

struct Unit { int pm, pn; };
struct Gemm { const bf16_t* A; const bf16_t* Bt; int M, N, K, lda, ldb; };

struct StaticOrder {
    int nM, nN, nwg, G, c;
    __host__ __device__ void init(int M, int N, int G_, int c_) { nM = M / BM; nN = N / BM; nwg = nM * nN; G = G_; c = c_; }
    __host__ __device__ bool next(int i, Unit& u) const {
        const long L = (long)i * G + c; if (L >= nwg) return false;
        int wgid = (int)L; { const int q = nwg / NXCD, r = nwg % NXCD, xcd = wgid % NXCD, off = wgid / NXCD; wgid = (xcd < r ? xcd * (q + 1) : r * (q + 1) + (xcd - r) * q) + off; }
        const int nig = WGM * nN, gid = wgid / nig, fm = gid * WGM, gsz = (nM - fm) < WGM ? (nM - fm) : WGM;
        u.pm = fm + ((wgid % nig) % gsz); u.pn = (wgid % nig) / gsz; return true;
    }
    __device__ __forceinline__ void a_ready(const Unit&) const {}
    __device__ __forceinline__ void done(const Unit&) const {}
};

typedef float f32x2 __attribute__((ext_vector_type(2)));
typedef __bf16 bf16x2_t __attribute__((ext_vector_type(2)));
__device__ __forceinline__ unsigned cvt_pk_bf16(float lo, float hi) { f32x2 v = {lo, hi}; bf16x2_t b = __builtin_convertvector(v, bf16x2_t); return __builtin_bit_cast(unsigned, b); }
__device__ __forceinline__ float bf_lo(unsigned w) { return __uint_as_float(w << 16); }
__device__ __forceinline__ float bf_hi(unsigned w) { return __uint_as_float(w & 0xffff0000u); }
__device__ __forceinline__ float fast_sigmoid(float v) { return __builtin_amdgcn_rcpf(1.0f + __builtin_amdgcn_exp2f(-1.4426950408889634f * v)); }

constexpr int DM = 1024, T_P = 65536, T_S = 32768, T_ALL = T_P + T_S, L_P = 4096, L_S = 16384;
constexpr int NIN = 5120, NQKV = 3072, NGATE = 2048, DFF = 2816, NGU = 2 * DFF, KBR = 768;
constexpr float EPS = 1e-6f;
constexpr float QSCALE = 0.125f * 1.4426950408889634f;


struct EpiInProj {
    static constexpr bool PERM = true, AFTER_DRAIN = false;
    bf16_t* QKV; bf16_t* G; const float* ss1; const f32x2* rope; const float* normt;
    __device__ __forceinline__ void operator()(const f32x4 (&acc)[2][2][4][2], const Unit& u, int wr, int wc, int fr, int fq) const {
        const int pn = u.pn; int row0 = u.pm * BM + wr * 64 + fr; asm volatile("" : "+v"(row0));
        if (pn >= 12) {
#pragma unroll
            for (int ai = 0; ai < 2; ++ai)
#pragma unroll
                for (int m = 0; m < 4; ++m) { const int row = row0 + ai * HALF + m * 16; const float rs = __builtin_amdgcn_rsqf(ss1[row] * (1.0f / DM) + EPS);
                    bf16_t* rowp = G + (size_t)row * NGATE + (pn - 12) * 256 + wc * 64 + fq * 8;
#pragma unroll
                    for (int bj = 0; bj < 2; ++bj) { const f32x4 v0 = acc[ai][bj][m][0] * rs, v1 = acc[ai][bj][m][1] * rs; u32x4 w;
                        w.x = cvt_pk_bf16(fast_sigmoid(v0[0]), fast_sigmoid(v0[1])); w.y = cvt_pk_bf16(fast_sigmoid(v0[2]), fast_sigmoid(v0[3]));
                        w.z = cvt_pk_bf16(fast_sigmoid(v1[0]), fast_sigmoid(v1[1])); w.w = cvt_pk_bf16(fast_sigmoid(v1[2]), fast_sigmoid(v1[3]));
                        *(u32x4*)(rowp + bj * 32) = w; } }
            return;
        }
        int kind, nidx;
        if (pn < 2) { kind = 1; nidx = 0; } else if (pn == 2) { kind = (wc < 2) ? 2 : 0; nidx = 1; } else if (pn < 6) { kind = 1; nidx = 2; } else if (pn < 9) { kind = 2; nidx = 3; } else { kind = 0; nidx = 3; }
        const float* nw = normt + nidx * 64;
        const int colb = pn * 256 + wc * 64 + fq * 8;
        if (kind == 0) {
#pragma unroll
            for (int ai = 0; ai < 2; ++ai)
#pragma unroll
                for (int m = 0; m < 4; ++m) { const int row = row0 + ai * HALF + m * 16; const float rs = __builtin_amdgcn_rsqf(ss1[row] * (1.0f / DM) + EPS);
                    bf16_t* rowp = QKV + (size_t)row * NQKV + colb;
#pragma unroll
                    for (int bj = 0; bj < 2; ++bj) { const f32x4 v0 = acc[ai][bj][m][0] * rs, v1 = acc[ai][bj][m][1] * rs; u32x4 w;
                        w.x = cvt_pk_bf16(v0[0], v0[1]); w.y = cvt_pk_bf16(v0[2], v0[3]); w.z = cvt_pk_bf16(v1[0], v1[1]); w.w = cvt_pk_bf16(v1[2], v1[3]);
                        *(u32x4*)(rowp + bj * 32) = w; } }
            return;
        }
        const float osc = (kind == 1) ? QSCALE : 1.0f;
        f32x4 gw[2][2];
#pragma unroll
        for (int bj = 0; bj < 2; ++bj)
#pragma unroll
            for (int n = 0; n < 2; ++n) gw[bj][n] = *(const f32x4*)(nw + bj * 32 + fq * 8 + n * 4);
#pragma unroll
        for (int ai = 0; ai < 2; ++ai)
#pragma unroll
            for (int m = 0; m < 4; ++m) { const int row = row0 + ai * HALF + m * 16; const float rs = __builtin_amdgcn_rsqf(ss1[row] * (1.0f / DM) + EPS);
                const int pos = (row < T_P) ? (row & (L_P - 1)) : (row & (L_S - 1));
                const f32x4* tp = (const f32x4*)(rope + (size_t)pos * 32 + fq * 8);
                f32x4 v[2][2]; float ssq = 0.f;
#pragma unroll
                for (int bj = 0; bj < 2; ++bj)
#pragma unroll
                    for (int n = 0; n < 2; ++n) { v[bj][n] = acc[ai][bj][m][n] * rs; ssq += (v[bj][n][0] * v[bj][n][0] + v[bj][n][1] * v[bj][n][1]) + (v[bj][n][2] * v[bj][n][2] + v[bj][n][3] * v[bj][n][3]); }
                ssq += __shfl_xor(ssq, 16); ssq += __shfl_xor(ssq, 32);
                const float r2 = __builtin_amdgcn_rsqf(ssq * (1.0f / 64.0f) + EPS);
#pragma unroll
                for (int bj = 0; bj < 2; ++bj)
#pragma unroll
                    for (int n = 0; n < 2; ++n) v[bj][n] = v[bj][n] * r2 * gw[bj][n];
                f32x4 olo[2], ohi[2];
#pragma unroll
                for (int n = 0; n < 2; ++n) { const f32x4 t0 = tp[2 * n], t1 = tp[2 * n + 1];
                    const f32x4 cs = (f32x4){t0[0], t0[2], t1[0], t1[2]}, sn = (f32x4){t0[1], t0[3], t1[1], t1[3]};
                    olo[n] = (v[0][n] * cs - v[1][n] * sn) * osc; ohi[n] = (v[1][n] * cs + v[0][n] * sn) * osc; }
                bf16_t* rowp = QKV + (size_t)row * NQKV + colb; u32x4 w;
                w.x = cvt_pk_bf16(olo[0][0], olo[0][1]); w.y = cvt_pk_bf16(olo[0][2], olo[0][3]); w.z = cvt_pk_bf16(olo[1][0], olo[1][1]); w.w = cvt_pk_bf16(olo[1][2], olo[1][3]);
                *(u32x4*)(rowp) = w;
                w.x = cvt_pk_bf16(ohi[0][0], ohi[0][1]); w.y = cvt_pk_bf16(ohi[0][2], ohi[0][3]); w.z = cvt_pk_bf16(ohi[1][0], ohi[1][1]); w.w = cvt_pk_bf16(ohi[1][2], ohi[1][3]);
                *(u32x4*)(rowp + 32) = w; }
    }
};

template <int SECOND> struct EpiBranch {
    static constexpr bool PERM = true, AFTER_DRAIN = false;
    bf16_t* G;
    __device__ __forceinline__ void operator()(const f32x4 (&acc)[2][2][4][2], const Unit& u, int wr, int wc, int fr, int fq) const {
        int row0 = u.pm * BM + wr * 64 + fr; asm volatile("" : "+v"(row0)); const int col0 = u.pn * BM + wc * 32 + 8 * fq;
#pragma unroll
        for (int ai = 0; ai < 2; ++ai)
#pragma unroll
            for (int m = 0; m < 4; ++m) { bf16_t* rowp = G + (size_t)(row0 + ai * HALF + m * 16) * NGATE + col0;
#pragma unroll
                for (int bj = 0; bj < 2; ++bj) { const f32x4 a0 = acc[ai][bj][m][0], a1 = acc[ai][bj][m][1];
                    const u32x4 gt = *(const u32x4*)(rowp + bj * HALF + (SECOND ? DM : 0));
                    float o[8] = {a0[0] * bf_lo(gt.x), a0[1] * bf_hi(gt.x), a0[2] * bf_lo(gt.y), a0[3] * bf_hi(gt.y), a1[0] * bf_lo(gt.z), a1[1] * bf_hi(gt.z), a1[2] * bf_lo(gt.w), a1[3] * bf_hi(gt.w)};
                    if (SECOND) { const u32x4 pv = *(const u32x4*)(rowp + bj * HALF);
                        o[0] += bf_lo(pv.x); o[1] += bf_hi(pv.x); o[2] += bf_lo(pv.y); o[3] += bf_hi(pv.y); o[4] += bf_lo(pv.z); o[5] += bf_hi(pv.z); o[6] += bf_lo(pv.w); o[7] += bf_hi(pv.w); }
                    u32x4 w; w.x = cvt_pk_bf16(o[0], o[1]); w.y = cvt_pk_bf16(o[2], o[3]); w.z = cvt_pk_bf16(o[4], o[5]); w.w = cvt_pk_bf16(o[6], o[7]);
                    *(u32x4*)(rowp + bj * HALF) = w; } }
    }
};

struct EpiOutProj {
    static constexpr bool PERM = false, AFTER_DRAIN = false;
    const float* xp; const float* xs; float* out; bf16_t* X1B; float* ss2;
    __device__ __forceinline__ void operator()(const f32x4 (&acc)[2][2][4][2], const Unit& u, int wr, int wc, int fr, int fq) const {
        const int rowt = u.pm * BM; const float* xb = (rowt < T_P) ? xp + (size_t)rowt * DM : xs + (size_t)(rowt - T_P) * DM;
        int rl0 = wr * 64 + fr; asm volatile("" : "+v"(rl0)); const int col0 = u.pn * BM + wc * 32 + 4 * fq;
#pragma unroll
        for (int ai = 0; ai < 2; ++ai)
#pragma unroll
            for (int m = 0; m < 4; ++m) { const int rl = rl0 + ai * HALF + m * 16; const size_t off = (size_t)rl * DM + col0; const size_t goff = (size_t)(rowt + rl) * DM + col0; float s = 0.f;
#pragma unroll
                for (int bj = 0; bj < 2; ++bj)
#pragma unroll
                    for (int n = 0; n < 2; ++n) { const f32x4 xv = *(const f32x4*)(xb + off + bj * HALF + n * 16); const f32x4 o = xv + acc[ai][bj][m][n];
                        *(f32x4*)(out + goff + bj * HALF + n * 16) = o; u32x2 w; w.x = cvt_pk_bf16(o[0], o[1]); w.y = cvt_pk_bf16(o[2], o[3]);
                        *(u32x2*)(X1B + goff + bj * HALF + n * 16) = w; s += (o[0] * o[0] + o[1] * o[1]) + (o[2] * o[2] + o[3] * o[3]); }
                s += __shfl_xor(s, 16); s += __shfl_xor(s, 32);
                if (fq == 0) atomicAdd(ss2 + rowt + rl, s); }
    }
};

struct EpiGateUp {
    static constexpr bool PERM = true, AFTER_DRAIN = false;
    bf16_t* ACT; const float* ss2;
    __device__ __forceinline__ void operator()(const f32x4 (&acc)[2][2][4][2], const Unit& u, int wr, int wc, int fr, int fq) const {
        int row0 = u.pm * BM + wr * 64 + fr; asm volatile("" : "+v"(row0)); const int col0 = u.pn * HALF + wc * 32 + 8 * fq;
#pragma unroll
        for (int ai = 0; ai < 2; ++ai)
#pragma unroll
            for (int m = 0; m < 4; ++m) { const int row = row0 + ai * HALF + m * 16; const float rs = __builtin_amdgcn_rsqf(ss2[row] * (1.0f / DM) + EPS);
                float o[8];
#pragma unroll
                for (int n = 0; n < 2; ++n)
#pragma unroll
                    for (int j = 0; j < 4; ++j) { const float g = acc[ai][0][m][n][j] * rs, up = acc[ai][1][m][n][j] * rs; o[4 * n + j] = g * fast_sigmoid(g) * up; }
                u32x4 w; w.x = cvt_pk_bf16(o[0], o[1]); w.y = cvt_pk_bf16(o[2], o[3]); w.z = cvt_pk_bf16(o[4], o[5]); w.w = cvt_pk_bf16(o[6], o[7]);
                *(u32x4*)(ACT + (size_t)row * DFF + col0) = w; }
    }
};

struct EpiDown {
    static constexpr bool PERM = false, AFTER_DRAIN = false;
    float* out;
    __device__ __forceinline__ void operator()(const f32x4 (&acc)[2][2][4][2], const Unit& u, int wr, int wc, int fr, int fq) const {
        int row0 = u.pm * BM + wr * 64 + fr; asm volatile("" : "+v"(row0)); const int col0 = u.pn * BM + wc * 32 + 4 * fq;
#pragma unroll
        for (int ai = 0; ai < 2; ++ai)
#pragma unroll
            for (int m = 0; m < 4; ++m) { const size_t off = (size_t)(row0 + ai * HALF + m * 16) * DM + col0;
#pragma unroll
                for (int bj = 0; bj < 2; ++bj)
#pragma unroll
                    for (int n = 0; n < 2; ++n) { float* p = out + off + bj * HALF + n * 16; *(f32x4*)p = *(const f32x4*)p + acc[ai][bj][m][n]; } }
    }
};

template <class Epi, class Sched, bool ALIGN_EPI = false, bool SP2 = false>
__device__ __forceinline__ void gemm_phase(PG8_LAS unsigned char* lds, const Gemm g, const Sched& S, const Epi& E) {
    const int tid = threadIdx.x, wid = __builtin_amdgcn_readfirstlane(tid >> 6), lane = tid & 63, wr = wid >> 2, wc = wid & 3, fr = lane & 15, fq = lane >> 4;
    const int K = g.K, nt = K / BK;
    unsigned voffA[2], voffB[2];
#pragma unroll
    for (int i = 0; i < 2; ++i) { int R, C; stage_rc(tid * 16 + i * 8192, R, C); const int Rb = Epi::PERM ? ((R & ~31) + perm32(R & 31)) : R;
        voffA[i] = (unsigned)(R * g.lda + C) * 2u; voffB[i] = (unsigned)(Rb * g.ldb + C) * 2u; }
    const size_t kstep = (size_t)(BK * 2);
    const size_t hstepA = (size_t)HALF * g.lda * 2, hstepB = (size_t)HALF * g.ldb * 2;
    const size_t tstepA = 2 * hstepA, tstepB = 2 * hstepB;
    const unsigned ldsw = (unsigned)wid * 1024u;
    const int aoff = lds_byte(wr * 64 + fr, fq * 8), boff = lds_byte(wc * 32 + fr, fq * 8);
#define PG8_SA(b, h) (((b) * 2 + (h)) * HTB)
#define PG8_SB(b, h) ((4 + (b) * 2 + (h)) * HTB)
#define PG8_STAGE(bufoff, gbase, voff) do { _Pragma("unroll") for (int _i = 0; _i < 2; ++_i) \
        __builtin_amdgcn_global_load_lds((const unsigned*)((const char*)(gbase) + (voff)[_i]), (PG8_LAS unsigned*)(lds + (bufoff) + ldsw + _i * 8192), 16, 0, 0); } while (0)
#define PG8_LDA(dst, b, h) do { _Pragma("unroll") for (int m = 0; m < 4; ++m) _Pragma("unroll") for (int k = 0; k < 2; ++k) dst[m][k] = *(const PG8_LAS bf16x8*)(lds + PG8_SA(b, h) + aoff + m * 2048 + k * 1024); } while (0)
#define PG8_LDB(dst, b, h) do { _Pragma("unroll") for (int n = 0; n < 2; ++n) _Pragma("unroll") for (int k = 0; k < 2; ++k) dst[n][k] = *(const PG8_LAS bf16x8*)(lds + PG8_SB(b, h) + boff + n * 2048 + k * 1024); } while (0)
#define PG8_MMA(ai, bj, At, Bt) do { __builtin_amdgcn_s_setprio(1); _Pragma("unroll") for (int m = 0; m < 4; ++m) _Pragma("unroll") for (int n = 0; n < 2; ++n) _Pragma("unroll") for (int k = 0; k < 2; ++k) \
        acc[ai][bj][m][n] = __builtin_amdgcn_mfma_f32_16x16x32_bf16(Bt[n][k], At[m][k], acc[ai][bj][m][n], 0, 0, 0); __builtin_amdgcn_s_setprio(0); } while (0)
#define PG8_WAIT_V(n) asm volatile("s_waitcnt vmcnt(" #n ")" ::: "memory")
#define PG8_WAIT_L(n) asm volatile("s_waitcnt lgkmcnt(" #n ")" ::: "memory")
#define PG8_BAR __builtin_amdgcn_s_barrier()
#define PG8_SCHED __builtin_amdgcn_sched_barrier(0)
    Unit cur, nxt; int ui = 0;
    if (!S.next(0, cur)) return;
    f32x4 acc[2][2][4][2];
#pragma unroll
    for (int a = 0; a < 2; ++a)
#pragma unroll
        for (int b = 0; b < 2; ++b)
#pragma unroll
            for (int m = 0; m < 4; ++m)
#pragma unroll
                for (int n = 0; n < 2; ++n) acc[a][b][m][n] = (f32x4){0.f, 0.f, 0.f, 0.f};
    bf16x8 At[4][2], B0[2][2], B1[2][2];
    const char* cA = (const char*)g.A + (size_t)cur.pm * tstepA; const char* cB = (const char*)g.Bt + (size_t)cur.pn * tstepB;
    S.a_ready(cur);
    if constexpr (SP2) {
        PG8_STAGE(PG8_SB(0, 0), cB, voffB); PG8_STAGE(PG8_SB(0, 1), cB + hstepB, voffB); PG8_STAGE(PG8_SA(0, 0), cA, voffA); PG8_STAGE(PG8_SA(0, 1), cA + hstepA, voffA);
        if (wr == 1) PG8_BAR;
        PG8_WAIT_V(2); PG8_BAR;
        PG8_STAGE(PG8_SB(1, 0), cB + kstep, voffB); PG8_STAGE(PG8_SA(1, 0), cA + kstep, voffA); PG8_STAGE(PG8_SB(1, 1), cB + hstepB + kstep, voffB);
        PG8_WAIT_V(6); PG8_BAR;
    } else {
        PG8_STAGE(PG8_SB(0, 0), cB, voffB); PG8_STAGE(PG8_SA(0, 0), cA, voffA); PG8_STAGE(PG8_SB(0, 1), cB + hstepB, voffB); PG8_STAGE(PG8_SA(0, 1), cA + hstepA, voffA);
        if (wr == 1) PG8_BAR;
        PG8_WAIT_V(4); PG8_BAR;
        PG8_STAGE(PG8_SB(1, 0), cB + kstep, voffB); PG8_STAGE(PG8_SA(1, 0), cA + kstep, voffA); PG8_STAGE(PG8_SB(1, 1), cB + hstepB + kstep, voffB);
        PG8_WAIT_V(6); PG8_BAR;
    }
    for (;;) {
        const bool has_next = S.next(ui + 1, nxt);
        const char* nA = has_next ? (const char*)g.A + (size_t)nxt.pm * tstepA : cA; const char* nB = has_next ? (const char*)g.Bt + (size_t)nxt.pn * tstepB : cB;
        for (int t = 0; t < nt; t += 2) {
            const bool last = (t == nt - 2);
            const char* a1 = cA + (size_t)(t + 1) * kstep;
            const char* a2 = last ? nA : cA + (size_t)(t + 2) * kstep; const char* b2 = last ? nB : cB + (size_t)(t + 2) * kstep;
            const char* a3 = a2 + kstep; const char* b3 = b2 + kstep;
            if (last && has_next) S.a_ready(nxt);
            if constexpr (SP2) {
            PG8_LDB(B0, 0, 0); PG8_LDB(B1, 0, 1); PG8_SCHED; PG8_LDA(At, 0, 0); PG8_STAGE(PG8_SA(1, 1), a1 + hstepA, voffA);
            PG8_WAIT_V(8); PG8_WAIT_L(0); PG8_BAR; PG8_MMA(0, 0, At, B0); PG8_MMA(0, 1, At, B1); PG8_BAR; PG8_SCHED;
            PG8_LDA(At, 0, 1); PG8_STAGE(PG8_SB(0, 0), b2, voffB); PG8_STAGE(PG8_SB(0, 1), b2 + hstepB, voffB); PG8_STAGE(PG8_SA(0, 0), a2, voffA);
            PG8_WAIT_V(8); PG8_WAIT_L(0); PG8_BAR; PG8_MMA(1, 0, At, B0); PG8_MMA(1, 1, At, B1); PG8_BAR; PG8_SCHED;
            PG8_LDB(B0, 1, 0); PG8_LDB(B1, 1, 1); PG8_SCHED; PG8_LDA(At, 1, 0); PG8_STAGE(PG8_SA(0, 1), a2 + hstepA, voffA);
            PG8_WAIT_V(8); PG8_WAIT_L(0); PG8_BAR; PG8_MMA(0, 0, At, B0); PG8_MMA(0, 1, At, B1); PG8_BAR; PG8_SCHED;
            PG8_LDA(At, 1, 1); PG8_STAGE(PG8_SB(1, 0), b3, voffB); PG8_STAGE(PG8_SB(1, 1), b3 + hstepB, voffB); PG8_STAGE(PG8_SA(1, 0), a3, voffA);
            PG8_WAIT_V(8); PG8_WAIT_L(0); PG8_BAR; PG8_MMA(1, 0, At, B0); PG8_MMA(1, 1, At, B1); PG8_BAR; PG8_SCHED;
            } else {
            PG8_LDB(B0, 0, 0); PG8_SCHED; PG8_LDA(At, 0, 0); PG8_STAGE(PG8_SA(1, 1), a1 + hstepA, voffA);
            PG8_WAIT_L(8); PG8_BAR; PG8_WAIT_L(0); PG8_MMA(0, 0, At, B0); PG8_BAR; PG8_SCHED;
            PG8_LDB(B1, 0, 1); PG8_STAGE(PG8_SB(0, 0), b2, voffB);
            PG8_BAR; PG8_WAIT_L(0); PG8_MMA(0, 1, At, B1); PG8_BAR;
            PG8_LDA(At, 0, 1); PG8_STAGE(PG8_SA(0, 0), a2, voffA);
            PG8_BAR; PG8_WAIT_L(0); PG8_MMA(1, 0, At, B0); PG8_BAR; PG8_SCHED;
            PG8_STAGE(PG8_SB(0, 1), b2 + hstepB, voffB);
            PG8_WAIT_V(6); PG8_BAR; PG8_MMA(1, 1, At, B1); PG8_BAR;
            PG8_LDB(B0, 1, 0); PG8_SCHED; PG8_LDA(At, 1, 0); PG8_STAGE(PG8_SA(0, 1), a2 + hstepA, voffA);
            PG8_WAIT_L(8); PG8_BAR; PG8_WAIT_L(0); PG8_MMA(0, 0, At, B0); PG8_BAR; PG8_SCHED;
            PG8_LDB(B1, 1, 1); PG8_STAGE(PG8_SB(1, 0), b3, voffB);
            PG8_BAR; PG8_WAIT_L(0); PG8_MMA(0, 1, At, B1); PG8_BAR;
            PG8_LDA(At, 1, 1); PG8_STAGE(PG8_SA(1, 0), a3, voffA);
            PG8_BAR; PG8_WAIT_L(0); PG8_MMA(1, 0, At, B0); PG8_BAR; PG8_SCHED;
            PG8_STAGE(PG8_SB(1, 1), b3 + hstepB, voffB);
            PG8_WAIT_V(6); PG8_BAR; PG8_MMA(1, 1, At, B1); PG8_BAR;
            }
        }
        if constexpr (ALIGN_EPI) { if (wr == 0) PG8_BAR; }
        if constexpr (!Epi::AFTER_DRAIN) { E(acc, cur, wr, wc, fr, fq); S.done(cur); }
        if (!has_next) break;
#pragma unroll
        for (int a = 0; a < 2; ++a)
#pragma unroll
            for (int b = 0; b < 2; ++b)
#pragma unroll
                for (int m = 0; m < 4; ++m)
#pragma unroll
                    for (int n = 0; n < 2; ++n) acc[a][b][m][n] = (f32x4){0.f, 0.f, 0.f, 0.f};
        cur = nxt; cA = nA; cB = nB; ++ui;
        if constexpr (ALIGN_EPI) { if (wr == 1) PG8_BAR; }
    }
    PG8_WAIT_V(0);
    if constexpr (!ALIGN_EPI) { if (wr == 0) PG8_BAR; }
    PG8_BAR;
    if constexpr (Epi::AFTER_DRAIN) { E.fused(acc, cur, wr, wc, fr, fq, lds, wid, lane); S.done(cur); }
#undef PG8_SA
#undef PG8_SB
#undef PG8_STAGE
#undef PG8_LDA
#undef PG8_LDB
#undef PG8_MMA
#undef PG8_WAIT_V
#undef PG8_WAIT_L
#undef PG8_BAR
#undef PG8_SCHED
}
}

using namespace pg8;
#define LAS __attribute__((address_space(3)))
typedef float f32x16 __attribute__((ext_vector_type(16)));
typedef short s16x4 __attribute__((ext_vector_type(4)));
typedef short v4i16_t __attribute__((ext_vector_type(4)));

constexpr size_t MiB = 1u << 20;
constexpr size_t WS_SS1 = 0, WS_SS2 = 512 * 1024, WS_NORMT = 960 * 1024;
constexpr size_t WS_ROPE = 1 * MiB;
constexpr size_t WS_LB = 5 * MiB;
constexpr size_t WS_WIN = 10 * MiB, WS_WBR = 20 * MiB, WS_WOUT = 22 * MiB, WS_WGU = 24 * MiB, WS_WD = 35 * MiB;
constexpr size_t WS_QKV = 42 * MiB;
constexpr size_t WS_G = 618 * MiB;
constexpr size_t WS_END = 1002 * MiB;
constexpr size_t WS_X1B = WS_QKV, WS_ACT = WS_QKV + 192 * MiB;
static_assert(WS_ACT + (size_t)T_ALL * DFF * 2 <= WS_END, "ws map");

constexpr int LDS_BYTES = 147456;
constexpr int AT_K = 0, AT_V = 49152, AT_WS = 98304, AT_OST = 100352;

__device__ __forceinline__ float wave_sum(float v) {
#pragma unroll
    for (int o = 1; o < 64; o <<= 1) v += __shfl_xor(v, o);
    return v;
}
__device__ __forceinline__ float wave_max(float v) {
#pragma unroll
    for (int o = 1; o < 64; o <<= 1) v = fmaxf(v, __shfl_xor(v, o));
    return v;
}

__device__ __forceinline__ void transpose_item(const float* W, int N, bf16_t* WT, int ldw, int kcol, const float* kscale, int mode, LAS float* scr, int item, int lane) {
    const int nblk = N / 32, kb = item / nblk, nb = item % nblk, k0 = 64 * kb, n0 = 32 * nb;
#pragma unroll 8
    for (int i = 0; i < 32; ++i) { const int kk = 2 * i + (lane >> 5); float v = W[(size_t)(k0 + kk) * N + n0 + (lane & 31)]; if (kscale) v *= kscale[k0 + kk]; scr[kk * 33 + (lane & 31)] = v; }
    asm volatile("s_waitcnt lgkmcnt(0)" ::: "memory");
    int rb;
    if (mode == 1) { const int np = n0 & 255; rb = (n0 & ~255) + 128 * ((np >> 5) & 1) + 32 * (np >> 6); }
    else if (mode == 2) rb = (n0 >> 7) * 256 + (n0 & 127);
    else if (mode == 3) rb = (n0 >> 7) * 256 + 128 + (n0 & 127);
    else rb = n0;
    const int c = lane & 7;
#pragma unroll
    for (int j = 0; j < 4; ++j) { const int n = (lane >> 3) + 8 * j; const LAS float* s = scr + (8 * c) * 33 + n;
        u32x4 o; o.x = cvt_pk_bf16(s[0 * 33], s[1 * 33]); o.y = cvt_pk_bf16(s[2 * 33], s[3 * 33]); o.z = cvt_pk_bf16(s[4 * 33], s[5 * 33]); o.w = cvt_pk_bf16(s[6 * 33], s[7 * 33]);
        *(u32x4*)(WT + (size_t)(rb + n) * ldw + kcol + k0 + 8 * c) = o; }
    asm volatile("s_waitcnt lgkmcnt(0)" ::: "memory");
}

struct Args {
    const float *x_prompt, *x_sample, *norm1, *w_in, *qn_a, *kn_a, *sink_a, *qn_b, *kn_b, *w_br_a, *w_br_b, *w_out, *norm2, *w_gate, *w_up, *w_down;
    float* out; unsigned char* ws;
    float inv_freq[32];
    int ph_lo, ph_hi;
};

__device__ __forceinline__ void p0_prologue(const Args& a, LAS unsigned char* lds, int vcu, int G) {
    const int lane = threadIdx.x & 63, wave = __builtin_amdgcn_readfirstlane(threadIdx.x >> 6);
    unsigned char* ws = a.ws;
    const int gtid = vcu * 512 + wave * 64 + lane, NT = G * 512;
    float* ss1 = (float*)(ws + WS_SS1); float* ss2 = (float*)(ws + WS_SS2);
    for (int i = gtid; i < T_ALL; i += NT) ss2[i] = 0.f;
    if (gtid < 256) { const int w = gtid >> 6, c = gtid & 63; ((float*)(ws + WS_NORMT))[gtid] = (w == 0) ? a.qn_a[c] : (w == 1) ? a.kn_a[c] : (w == 2) ? a.qn_b[c] : a.kn_b[c]; }
    f32x2* rope = (f32x2*)(ws + WS_ROPE);
    for (int i = gtid; i < 16384 * 32; i += NT) { const int pos = i >> 5, c = i & 31; const float ang = (float)pos * a.inv_freq[c];
        double rev = (double)ang * 0.15915494309189535; rev -= floor(rev); const float fr = (float)rev;
        rope[i] = (f32x2){__builtin_amdgcn_cosf(fr), __builtin_amdgcn_sinf(fr)}; }
    LAS float* scr = (LAS float*)(lds + wave * 16384);
    const int gw = vcu * 8 + wave, NGW = G * 8;
    constexpr int I_IN = (DM / 64) * (NIN / 32), I_BA = (512 / 64) * (DM / 32), I_BB = (256 / 64) * (DM / 32), I_OUT = (DM / 64) * (DM / 32), I_G = (DM / 64) * (DFF / 32), I_D = (DFF / 64) * (DM / 32);
    constexpr int NITEMS = I_IN + I_BA + I_BB + I_OUT + 2 * I_G + I_D;
    bf16_t* WinT = (bf16_t*)(ws + WS_WIN); bf16_t* WbrT = (bf16_t*)(ws + WS_WBR); bf16_t* WoutT = (bf16_t*)(ws + WS_WOUT); bf16_t* WguT = (bf16_t*)(ws + WS_WGU); bf16_t* WdT = (bf16_t*)(ws + WS_WD);
    for (int it = gw; it < NITEMS; it += NGW) {
        int r = it;
        if (r < I_IN) { transpose_item(a.w_in, NIN, WinT, DM, 0, a.norm1, 1, scr, r, lane); continue; } r -= I_IN;
        if (r < I_BA) { transpose_item(a.w_br_a, DM, WbrT, KBR, 0, nullptr, 0, scr, r, lane); continue; } r -= I_BA;
        if (r < I_BB) { transpose_item(a.w_br_b, DM, WbrT, KBR, 512, nullptr, 0, scr, r, lane); continue; } r -= I_BB;
        if (r < I_OUT) { transpose_item(a.w_out, DM, WoutT, DM, 0, nullptr, 0, scr, r, lane); continue; } r -= I_OUT;
        if (r < I_G) { transpose_item(a.w_gate, DFF, WguT, DM, 0, a.norm2, 2, scr, r, lane); continue; } r -= I_G;
        if (r < I_G) { transpose_item(a.w_up, DFF, WguT, DM, 0, a.norm2, 3, scr, r, lane); continue; } r -= I_G;
        transpose_item(a.w_down, DM, WdT, DFF, 0, nullptr, 0, scr, r, lane);
    }
    bf16_t* XB = (bf16_t*)a.out;
    for (int m = gw; m < T_ALL; m += NGW) {
        const float* xrow = (m < T_P) ? a.x_prompt + (size_t)m * DM : a.x_sample + (size_t)(m - T_P) * DM;
        const f32x4* xr = (const f32x4*)xrow + lane; f32x4 v[4]; float s = 0.f;
#pragma unroll
        for (int j = 0; j < 4; ++j) { v[j] = xr[64 * j]; s += (v[j][0] * v[j][0] + v[j][1] * v[j][1]) + (v[j][2] * v[j][2] + v[j][3] * v[j][3]); }
        s = wave_sum(s);
        u32x2* o8 = (u32x2*)(XB + (size_t)m * DM) + lane;
#pragma unroll
        for (int j = 0; j < 4; ++j) { u32x2 w; w.x = cvt_pk_bf16(v[j][0], v[j][1]); w.y = cvt_pk_bf16(v[j][2], v[j][3]); o8[64 * j] = w; }
        if (lane == 0) ss1[m] = s;
    }
}

__device__ __forceinline__ int crow(int r, int hi) { return (r & 3) + 8 * (r >> 2) + 4 * hi; }
template <int NTL, int NTW, bool IS_A>
__device__ __forceinline__ void attn_unit(LAS unsigned char* lds, bf16_t* QKV, float* LB, size_t row0, int dstr, int res, int Lf, int qcol, int kcol, int vcol, int jq0, int jk0, int t_lo, int W,
                                          float negM2, float sink2, int lbcol) {
    const int tid = threadIdx.x, lane = tid & 63, wave = __builtin_amdgcn_readfirstlane(tid >> 6);
    const int r32 = lane & 31, hi = lane >> 5;
    bf16x8 qr[4];
    { const size_t qtok = row0 + (size_t)(jq0 + r32) * dstr + res; const bf16_t* qp = QKV + qtok * NQKV + qcol + hi * 8;
#pragma unroll
      for (int d0 = 0; d0 < 4; ++d0) qr[d0] = *(const bf16x8*)(qp + d0 * 16); }
    { u32x4 kreg[NTL], vreg[NTL]; const int row = tid >> 3, c = tid & 7;
#pragma unroll
      for (int t = 0; t < NTL; ++t) { int j = jk0 + 64 * t + row; j = j < 0 ? 0 : (j >= Lf ? Lf - 1 : j); const bf16_t* tp = QKV + (row0 + (size_t)j * dstr + res) * NQKV + c * 8;
          kreg[t] = *(const u32x4*)(tp + kcol); vreg[t] = *(const u32x4*)(tp + vcol); }
      LAS unsigned char* kd = lds + AT_K + c * 1024 + row * 16;
      LAS unsigned char* vd = lds + AT_V + ((c >> 2) * 4 + (row >> 4)) * 1024 + (row & 15) * 64 + (c & 3) * 16;
#pragma unroll
      for (int t = 0; t < NTL; ++t) { *(LAS u32x4*)(kd + t * 8192) = kreg[t]; *(LAS u32x4*)(vd + t * 8192) = vreg[t]; } }
    __syncthreads();
    f32x16 o[2]; float lsum = 0.f;
#pragma unroll
    for (int r = 0; r < 16; ++r) { o[0][r] = 0.f; o[1][r] = 0.f; }
    const int qj = jq0 + r32;
    const LAS unsigned char* kp0 = lds + AT_K + hi * 1024 + r32 * 16;
    const LAS unsigned char* vp0 = lds + AT_V + ((lane >> 4) & 1) * 32 + (lane & 3) * 8 + (4 * hi + ((lane & 15) >> 2)) * 64;
#pragma unroll 1
    for (int tt = 0; tt < NTW; ++tt) { const int t = t_lo + tt;
        f32x16 p0, p1;
#pragma unroll
        for (int r = 0; r < 16; ++r) { p0[r] = negM2; p1[r] = negM2; }
        const LAS unsigned char* kp = kp0 + t * 8192;
#pragma unroll
        for (int d0 = 0; d0 < 4; ++d0) { const bf16x8 b0 = *(const LAS bf16x8*)(kp + d0 * 2048), b1 = *(const LAS bf16x8*)(kp + d0 * 2048 + 512);
            p0 = __builtin_amdgcn_mfma_f32_32x32x16_bf16(b0, qr[d0], p0, 0, 0, 0); p1 = __builtin_amdgcn_mfma_f32_32x32x16_bf16(b1, qr[d0], p1, 0, 0, 0); }
        const int kb = jk0 + 64 * t + 4 * hi;
#pragma unroll
        for (int r = 0; r < 16; ++r) { const int k0 = kb + (r & 3) + 8 * (r >> 2), k1 = k0 + 32;
            const bool v0 = ((unsigned)(k0 - qj + W) <= (unsigned)(2 * W)) && ((unsigned)k0 < (unsigned)Lf), v1 = ((unsigned)(k1 - qj + W) <= (unsigned)(2 * W)) && ((unsigned)k1 < (unsigned)Lf);
            p0[r] = v0 ? __builtin_amdgcn_exp2f(p0[r]) : 0.f; p1[r] = v1 ? __builtin_amdgcn_exp2f(p1[r]) : 0.f; lsum += p0[r] + p1[r]; }
        u32x4 pw[4];
#pragma unroll
        for (int i = 0; i < 4; ++i) { pw[0][i] = cvt_pk_bf16(p0[2 * i], p0[2 * i + 1]); pw[1][i] = cvt_pk_bf16(p0[8 + 2 * i], p0[9 + 2 * i]); pw[2][i] = cvt_pk_bf16(p1[2 * i], p1[2 * i + 1]); pw[3][i] = cvt_pk_bf16(p1[8 + 2 * i], p1[9 + 2 * i]); }
        const LAS unsigned char* vp = vp0 + t * 8192;
#pragma unroll
        for (int d0 = 0; d0 < 2; ++d0)
#pragma unroll
            for (int ks = 0; ks < 4; ++ks) {
                const s16x4 lo = __builtin_bit_cast(s16x4, __builtin_amdgcn_ds_read_tr16_b64_v4i16((LAS v4i16_t*)(vp + d0 * 4096 + ks * 1024)));
                const s16x4 hh = __builtin_bit_cast(s16x4, __builtin_amdgcn_ds_read_tr16_b64_v4i16((LAS v4i16_t*)(vp + d0 * 4096 + ks * 1024 + 512)));
                const bf16x8 vf = (bf16x8){lo[0], lo[1], lo[2], lo[3], hh[0], hh[1], hh[2], hh[3]};
                o[d0] = __builtin_amdgcn_mfma_f32_32x32x16_bf16(__builtin_bit_cast(bf16x8, pw[ks]), vf, o[d0], 0, 0, 0); }
    }
    lsum += __shfl_xor(lsum, 32);
    LAS float* wsf = (LAS float*)(lds + AT_WS) + wave * 64;
    LAS bf16_t* stg = (LAS bf16_t*)(lds + AT_OST) + wave * 2048;
    if (IS_A) { lsum += __builtin_amdgcn_exp2f(sink2); if (hi == 0) wsf[r32] = __builtin_amdgcn_rcpf(lsum); }
    else { if (hi == 0) LB[(row0 + (size_t)(jq0 + r32) * dstr + res) * 12 + lbcol] = lsum; }
    asm volatile("s_waitcnt lgkmcnt(0)" ::: "memory");
#pragma unroll
    for (int r = 0; r < 16; ++r) { const int orow = crow(r, hi); const float sc = IS_A ? wsf[orow] : 1.0f;
#pragma unroll
        for (int d0 = 0; d0 < 2; ++d0) { const unsigned w = cvt_pk_bf16(o[d0][r] * sc, 0.f); stg[orow * 64 + d0 * 32 + r32] = (bf16_t)(w & 0xffffu); } }
    asm volatile("s_waitcnt lgkmcnt(0)" ::: "memory");
#pragma unroll
    for (int i = 0; i < 4; ++i) { const int row = i * 8 + (lane >> 3), ch = lane & 7; const u32x4 v = *(const LAS u32x4*)(stg + row * 64 + ch * 8);
        *(u32x4*)(QKV + (row0 + (size_t)(jq0 + row) * dstr + res) * NQKV + qcol + ch * 8) = v; }
    __syncthreads();
}

__device__ __forceinline__ void attention_phase(const Args& a, LAS unsigned char* lds, int vcu, int G) {
    const int lane = threadIdx.x & 63, wave = __builtin_amdgcn_readfirstlane(threadIdx.x >> 6);
    bf16_t* QKV = (bf16_t*)(a.ws + WS_QKV); float* LB = (float*)(a.ws + WS_LB);
    const float mqa = wave_max(fabsf(a.qn_a[lane])), mka = wave_max(fabsf(a.kn_a[lane])), mqb = wave_max(fabsf(a.qn_b[lane])), mkb = wave_max(fabsf(a.kn_b[lane]));
    const float M2a = 64.0f * QSCALE * mqa * mka, M2b = 64.0f * QSCALE * mqb * mkb;
    constexpr int NUA = (T_ALL / 64) * 2;
    { const int per = (NUA + G - 1) / G;
      for (int i = 0; i < per; ++i) { const int u = vcu * per + i; if (u >= NUA) break;
          const int qt = u >> 1, kvh = u & 1; const int tok0 = qt * 64; size_t row0; int L;
          if (tok0 < T_P) { row0 = (size_t)(tok0 & ~(L_P - 1)); L = L_P; } else { row0 = (size_t)(tok0 & ~(L_S - 1)); L = L_S; }
          const int q0 = tok0 - (int)row0; const int head = kvh * 4 + (wave >> 1);
          const float sink2 = a.sink_a[head] * 1.4426950408889634f - M2a;
          attn_unit<5, 5, true>(lds, QKV, LB, row0, 1, 0, L, head * 64, 512 + kvh * 64, 640 + kvh * 64, q0 + 32 * (wave & 1), q0 - 128, 0, 128, -M2a, sink2, 0); } }
    constexpr int NSL = T_ALL / 256, NUB = 12 * NSL;
    { const int per = (NUB + G - 1) / G;
      for (int i = 0; i < per; ++i) { const int u = vcu * per + i; if (u >= NUB) break;
          const int hb = u / NSL, sl = u % NSL; const int g = hb >> 2; const int d = (g == 0) ? 1 : (g == 1 ? 4 : 16);
          size_t row0; int L, e;
          if (sl < T_P / 256) { row0 = (size_t)(sl / (L_P / 256)) * L_P; e = sl % (L_P / 256); L = L_P; } else { const int s2 = sl - T_P / 256; row0 = (size_t)T_P + (size_t)(s2 / (L_S / 256)) * L_S; e = s2 % (L_S / 256); L = L_S; }
          const int res = e % d, fb = e / d, Lf = L / d, j0 = fb * 256;
          attn_unit<6, 3, false>(lds, QKV, LB, row0, d, res, Lf, 768 + hb * 64, 1536 + hb * 64, 2304 + hb * 64, j0 + 32 * wave, j0 - 64, wave >> 1, 64, -M2b, 0.f, hb); } }
}

__device__ __forceinline__ void combine_phase(const Args& a, int vcu, int G) {
    const int tid = threadIdx.x;
    bf16_t* QKV = (bf16_t*)(a.ws + WS_QKV); const float* LB = (const float*)(a.ws + WS_LB);
    const int NT = G * 512;
    for (int i = vcu * 512 + tid; i < T_ALL * 32; i += NT) { const size_t tok = (size_t)(i >> 5); const int hp = (i >> 3) & 3, ch = i & 7;
        float l = 0.f; float o[8] = {0.f, 0.f, 0.f, 0.f, 0.f, 0.f, 0.f, 0.f};
#pragma unroll
        for (int g = 0; g < 3; ++g) { l += LB[tok * 12 + 4 * g + hp]; const u32x4 v = *(const u32x4*)(QKV + tok * NQKV + 768 + (4 * g + hp) * 64 + ch * 8);
            o[0] += bf_lo(v.x); o[1] += bf_hi(v.x); o[2] += bf_lo(v.y); o[3] += bf_hi(v.y); o[4] += bf_lo(v.z); o[5] += bf_hi(v.z); o[6] += bf_lo(v.w); o[7] += bf_hi(v.w); }
        const float rl = 1.0f / l; u32x4 w; w.x = cvt_pk_bf16(o[0] * rl, o[1] * rl); w.y = cvt_pk_bf16(o[2] * rl, o[3] * rl); w.z = cvt_pk_bf16(o[4] * rl, o[5] * rl); w.w = cvt_pk_bf16(o[6] * rl, o[7] * rl);
        *(u32x4*)(QKV + tok * NQKV + 512 + hp * 64 + ch * 8) = w; }
}

constexpr int NPH = 8;
__global__ void __launch_bounds__(512, 2) fwd_megakernel(Args args) {
    extern __shared__ __attribute__((aligned(16))) unsigned char lds_raw[];
    LAS unsigned char* lds = (LAS unsigned char*)lds_raw;
    const int G = gridDim.x, bx = blockIdx.x; const int vcu = (G % 8 == 0) ? (bx % 8) * (G / 8) + bx / 8 : bx;
    unsigned char* ws = args.ws;
    const int lo = args.ph_lo, hi = args.ph_hi;
#define IN(k) (lo <= (k) && (k) < hi)
#define SEAM(k) do { if (IN(k) && IN((k) + 1)) { cg::this_grid().sync(); } } while (0)
    bf16_t* QKV = (bf16_t*)(ws + WS_QKV); bf16_t* Gt = (bf16_t*)(ws + WS_G);
    float* ss1 = (float*)(ws + WS_SS1); float* ss2 = (float*)(ws + WS_SS2);
    if (IN(0)) { p0_prologue(args, lds, vcu, G); }
    SEAM(0);
    if (IN(1)) {
        Gemm g{(const bf16_t*)args.out, (const bf16_t*)(ws + WS_WIN), T_ALL, NIN, DM, DM, DM}; StaticOrder S; S.init(T_ALL, NIN, G, bx);
        EpiInProj E{QKV, Gt, ss1, (const f32x2*)(ws + WS_ROPE), (const float*)(ws + WS_NORMT)};
        gemm_phase<EpiInProj, StaticOrder, true, true>(lds, g, S, E);
    }
    SEAM(1);
    if (IN(2)) { attention_phase(args, lds, vcu, G); }
    SEAM(2);
    if (IN(3)) { combine_phase(args, vcu, G); }
    SEAM(3);
    if (IN(4)) {
        { Gemm g{QKV, (const bf16_t*)(ws + WS_WBR), T_ALL, DM, 512, NQKV, KBR}; StaticOrder S; S.init(T_ALL, DM, G, bx); EpiBranch<0> E{Gt};
          gemm_phase<EpiBranch<0>, StaticOrder, true, true>(lds, g, S, E); }
        __syncthreads();
        { Gemm g{QKV + 512, (const bf16_t*)(ws + WS_WBR) + 512, T_ALL, DM, 256, NQKV, KBR}; StaticOrder S; S.init(T_ALL, DM, G, bx); EpiBranch<1> E{Gt};
          gemm_phase<EpiBranch<1>, StaticOrder, true, true>(lds, g, S, E); }
    }
    SEAM(4);
    if (IN(5)) {
        Gemm g{Gt, (const bf16_t*)(ws + WS_WOUT), T_ALL, DM, DM, NGATE, DM}; StaticOrder S; S.init(T_ALL, DM, G, bx);
        EpiOutProj E{args.x_prompt, args.x_sample, args.out, (bf16_t*)(ws + WS_X1B), ss2};
        gemm_phase<EpiOutProj, StaticOrder, true, true>(lds, g, S, E);
    }
    SEAM(5);
    if (IN(6)) {
        Gemm g{(const bf16_t*)(ws + WS_X1B), (const bf16_t*)(ws + WS_WGU), T_ALL, NGU, DM, DM, DM}; StaticOrder S; S.init(T_ALL, NGU, G, bx);
        EpiGateUp E{(bf16_t*)(ws + WS_ACT), ss2};
        gemm_phase<EpiGateUp, StaticOrder, true, true>(lds, g, S, E);
    }
    SEAM(6);
    if (IN(7)) {
        Gemm g{(const bf16_t*)(ws + WS_ACT), (const bf16_t*)(ws + WS_WD), T_ALL, DM, DFF, DFF, DFF}; StaticOrder S; S.init(T_ALL, DM, G, bx);
        EpiDown E{args.out};
        gemm_phase<EpiDown, StaticOrder, true, true>(lds, g, S, E);
    }
#undef IN
#undef SEAM
}

#ifndef MK_N_LAUNCHES
#define MK_N_LAUNCHES 8
#endif

extern "C" void kernel_launch(void* const* d_in, const int* in_sizes, int n_in, void* d_out, int out_size, void* d_ws, size_t ws_size, hipStream_t stream) {
    static int grid = 0;
    if (grid == 0) {
        if (n_in != 16 || out_size != T_ALL * DM || ws_size < WS_END) { fprintf(stderr, "kernel_launch: unexpected shapes: n_in %d out %d ws %zu (need %zu)\n", n_in, out_size, ws_size, (size_t)WS_END); grid = -1; return; }
        int dev = 0, cus = 0, per_cu = 0;
        hipGetDevice(&dev); hipDeviceGetAttribute(&cus, hipDeviceAttributeMultiprocessorCount, dev);
        if (hipFuncSetAttribute((const void*)fwd_megakernel, hipFuncAttributeMaxDynamicSharedMemorySize, LDS_BYTES) != hipSuccess) { fprintf(stderr, "kernel_launch: hipFuncSetAttribute failed\n"); grid = -1; return; }
        if (hipOccupancyMaxActiveBlocksPerMultiprocessor(&per_cu, (const void*)fwd_megakernel, 512, LDS_BYTES) != hipSuccess || per_cu < 1) { fprintf(stderr, "kernel_launch: occupancy query says %d\n", per_cu); per_cu = 1; }
        (void)hipGetLastError();
        grid = cus * 1;
        fprintf(stderr, "kernel_launch: cus %d per_cu %d grid %d\n", cus, per_cu, grid);
    }
    if (grid < 0) return;
    Args a{};
    a.x_prompt = (const float*)d_in[0]; a.x_sample = (const float*)d_in[1]; a.norm1 = (const float*)d_in[2]; a.w_in = (const float*)d_in[3]; a.qn_a = (const float*)d_in[4]; a.kn_a = (const float*)d_in[5];
    a.sink_a = (const float*)d_in[6]; a.qn_b = (const float*)d_in[7]; a.kn_b = (const float*)d_in[8]; a.w_br_a = (const float*)d_in[9]; a.w_br_b = (const float*)d_in[10]; a.w_out = (const float*)d_in[11];
    a.norm2 = (const float*)d_in[12]; a.w_gate = (const float*)d_in[13]; a.w_up = (const float*)d_in[14]; a.w_down = (const float*)d_in[15];
    a.out = (float*)d_out; a.ws = (unsigned char*)d_ws;
    for (int c = 0; c < 32; ++c) a.inv_freq[c] = (float)pow(10000.0, -(double)c / 32.0);
#if MK_N_LAUNCHES == 1
    a.ph_lo = 0; a.ph_hi = NPH;
    void* kargs[] = {&a};
    hipError_t e = hipLaunchCooperativeKernel((const void*)fwd_megakernel, dim3(grid), dim3(512), kargs, LDS_BYTES, stream);
    if (e != hipSuccess) fprintf(stderr, "kernel_launch: cooperative launch failed: %s (grid %d)\n", hipGetErrorString(e), grid);
#else
    for (int p = 0; p < NPH; ++p) { a.ph_lo = p; a.ph_hi = p + 1; hipLaunchKernelGGL(fwd_megakernel, dim3(grid), dim3(512), LDS_BYTES, stream, a); }
#endif
}
```

```cpp
#include <hip/hip_runtime.h>
#include <hip/hip_cooperative_groups.h>
#include <cstdio>
#include <cstdint>
#include <cmath>
namespace cg = cooperative_groups;

namespace pg8 {
#define PG8_LAS __attribute__((address_space(3)))
typedef unsigned short bf16_t;
typedef short bf16x8 __attribute__((ext_vector_type(8)));
typedef float f32x4 __attribute__((ext_vector_type(4)));
typedef unsigned u32x4 __attribute__((ext_vector_type(4)));
typedef unsigned u32x2 __attribute__((ext_vector_type(2)));
__device__ __forceinline__ int lane_id() { return (int)__builtin_amdgcn_mbcnt_hi(~0u, __builtin_amdgcn_mbcnt_lo(~0u, 0u)); }
typedef int v4i_t __attribute__((ext_vector_type(4)));
typedef int v8i_t __attribute__((ext_vector_type(8)));
__device__ __forceinline__ v8i_t cat8(bf16x8 lo, bf16x8 hi) { const v4i_t a = __builtin_bit_cast(v4i_t, lo), b = __builtin_bit_cast(v4i_t, hi); return __builtin_shufflevector(a, b, 0, 1, 2, 3, 4, 5, 6, 7); }
constexpr int BM = 256, BK = 64, HALF = 128, HTB = HALF * BK * 2  , STAGE_BYTES = 8 * HTB, NXCD = 8, WGM = 8;

__host__ __device__ __forceinline__ int lds_byte(int r, int c) { const int st = (r >> 4) * 2 + (c >> 5), rr = r & 15, cc = c & 31, ob = rr * 64 + cc * 2; return st * 1024 + (ob ^ (((ob >> 9) & 1) << 5)); }
__host__ __device__ __forceinline__ void stage_rc(int b, int& R, int& C) { const int st = b / 1024, sb = b % 1024, swz = sb ^ (((sb >> 9) & 1) << 5); R = (st >> 1) * 16 + swz / 64; C = (st & 1) * 32 + (swz % 64) / 2; }
__host__ __device__ __forceinline__ int perm32(int rho) { const int n = rho >> 4, i = rho & 15; return 8 * (i >> 2) + 4 * n + (i & 3); }

struct Unit { int pm, pn; };
struct Gemm { const bf16_t* A; const bf16_t* Bt; int M, N, K, lda, ldb; };

struct StaticOrder {
    int nM, nN, nwg, G, c;
    __host__ __device__ void init(int M, int N, int G_, int c_) { nM = M / BM; nN = N / BM; nwg = nM * nN; G = G_; c = c_; }
    __host__ __device__ bool next(int i, Unit& u) const {
        const long L = (long)i * G + c; if (L >= nwg) return false;
        int wgid = (int)L; { const int q = nwg / NXCD, r = nwg % NXCD, xcd = wgid % NXCD, off = wgid / NXCD; wgid = (xcd < r ? xcd * (q + 1) : r * (q + 1) + (xcd - r) * q) + off; }
        const int nig = WGM * nN, gid = wgid / nig, fm = gid * WGM, gsz = (nM - fm) < WGM ? (nM - fm) : WGM;
        u.pm = fm + ((wgid % nig) % gsz); u.pn = (wgid % nig) / gsz; return true;
    }
    __device__ __forceinline__ void a_ready(const Unit&) const {}
    __device__ __forceinline__ void done(const Unit&) const {}
};

struct InProjOrder : StaticOrder {
    __device__ bool next(int i, Unit& u) const { const bool ok = StaticOrder::next(i, u); if (ok) u.pn = (u.pn == 8) ? 9 : (u.pn == 9) ? 10 : (u.pn == 10) ? 8 : u.pn; return ok; }
};
typedef float f32x2 __attribute__((ext_vector_type(2)));
typedef __bf16 bf16x2_t __attribute__((ext_vector_type(2)));
__device__ __forceinline__ unsigned cvt_pk_bf16(float lo, float hi) { f32x2 v = {lo, hi}; bf16x2_t b = __builtin_convertvector(v, bf16x2_t); return __builtin_bit_cast(unsigned, b); }
__device__ __forceinline__ unsigned cvt_pk_fp8x4(float a, float b, float c, float d) { int w = 0; w = __builtin_amdgcn_cvt_pk_fp8_f32(a, b, w, false); w = __builtin_amdgcn_cvt_pk_fp8_f32(c, d, w, true); return (unsigned)w; }
constexpr float X8_SCALE = 16.0f, W8_SCALE = 512.0f, MIX8_SCALE = 64.0f, AO8_SCALE = 32.0f, WBR8_SCALE = 256.0f;
__device__ __forceinline__ float bf_lo(unsigned w) { return __uint_as_float(w << 16); }
__device__ __forceinline__ float bf_hi(unsigned w) { return __uint_as_float(w & 0xffff0000u); }
__device__ __forceinline__ float fast_sigmoid(float v) { return __builtin_amdgcn_rcpf(1.0f + __builtin_amdgcn_exp2f(-1.4426950408889634f * v)); }

constexpr int DM = 1024, T_P = 65536, T_S = 32768, T_ALL = T_P + T_S, L_P = 4096, L_S = 16384;
constexpr int NIN = 5120, NQKV = 3072, NGATE = 2048, DFF = 2816, NGU = 2 * DFF, KBR = 768;
constexpr float EPS = 1e-6f;
constexpr float QSCALE = 0.125f * 1.4426950408889634f;


__device__ __forceinline__ size_t qh_tau(int hs, int row) {
    if (hs < 12) return (size_t)row;
    const int sh = 2 * (((hs - 12) % 12) >> 2);
    const int Lm = (row < T_P) ? (L_P - 1) : (L_S - 1), lsh = (row < T_P) ? 12 : 14, pos = row & Lm;
    return (size_t)((row & ~Lm) + ((pos & ((1 << sh) - 1)) << (lsh - sh)) + (pos >> sh));
}
#define LANE_FRFQ int ln_ = lane_id(); asm volatile("" : "+v"(ln_)); const int fr = ln_ & 15, fq = ln_ >> 4
#define SHFLX(x, m) __int_as_float(__builtin_amdgcn_ds_bpermute((ln_ ^ (m)) << 2, __float_as_int(x)))
#define ROT4(c, s, rc, rs_) do { const f32x4 _c = c * rc - s * rs_; s = s * rc + c * rs_; c = _c; } while (0)
struct EpiInProj {
    static constexpr bool PERM = true, AFTER_DRAIN = false;
    bf16_t* QKV; bf16_t* G; const float* ss1; const f32x2* rope; const PG8_LAS float* ltab; float oscale;
    __device__ __forceinline__ void operator()(const f32x4 (&acc)[2][2][4][2], const Unit& u, int wr, int wc, int, int) const {
        LANE_FRFQ; const int pn = u.pn; int row0 = u.pm * BM + wr * 64 + fr; asm volatile("" : "+v"(row0));
        float rsv[8];
#pragma unroll
        for (int i = 0; i < 8; ++i) rsv[i] = ss1[row0 + (i >> 2) * HALF + (i & 3) * 16];
        int kind, nidx;
        if (pn < 2) { kind = 1; nidx = 0; } else if (pn == 2) { kind = (wc < 2) ? 2 : 0; nidx = 1; } else if (pn < 6) { kind = 1; nidx = 2; } else if (pn < 9) { kind = 2; nidx = 3; } else if (pn < 12) { kind = 0; nidx = 3; } else { kind = 3; nidx = 3; }
        if (kind == 3) {
#pragma unroll
            for (int i = 0; i < 8; ++i) { const int ai = i >> 2, m = i & 3; const float rs = __builtin_amdgcn_rsqf(rsv[i] * (1.0f / DM) + EPS) * oscale * -1.4426950408889634f;
                bf16_t* rowp = G + (size_t)(row0 + ai * HALF + m * 16) * NGATE + (pn - 12) * 128 + wc * 32 + fq * 8;
                float r[8], gb[8];
#pragma unroll
                for (int n = 0; n < 2; ++n)
#pragma unroll
                    for (int j = 0; j < 4; ++j) { const float ea = __builtin_amdgcn_exp2f(acc[ai][0][m][n][j] * rs), eb = __builtin_amdgcn_exp2f(acc[ai][1][m][n][j] * rs);
                        gb[4 * n + j] = __builtin_amdgcn_rcpf(1.0f + eb); r[4 * n + j] = (1.0f + eb) * __builtin_amdgcn_rcpf(1.0f + ea); }
                u32x4 w; w.x = cvt_pk_bf16(r[0], r[1]); w.y = cvt_pk_bf16(r[2], r[3]); w.z = cvt_pk_bf16(r[4], r[5]); w.w = cvt_pk_bf16(r[6], r[7]);
                __builtin_nontemporal_store(w, (u32x4*)rowp);
                w.x = cvt_pk_bf16(gb[0], gb[1]); w.y = cvt_pk_bf16(gb[2], gb[3]); w.z = cvt_pk_bf16(gb[4], gb[5]); w.w = cvt_pk_bf16(gb[6], gb[7]);
                __builtin_nontemporal_store(w, (u32x4*)(rowp + DM)); }
            return;
        }
        if (kind == 0) {
            const int hs = 4 * pn + wc, sh = (hs < 12) ? 0 : 2 * (((hs - 12) % 12) >> 2);
            bf16_t* qbase = QKV + ((size_t)hs * T_ALL + qh_tau(hs, row0)) * 64 + fq * 8;
#pragma unroll
            for (int i = 0; i < 8; ++i) { const int ai = i >> 2, m = i & 3; const float rs = __builtin_amdgcn_rsqf(rsv[i] * (1.0f / DM) + EPS) * oscale;
                bf16_t* rowp = qbase + (size_t)((ai * HALF + m * 16) >> sh) * 64;
#pragma unroll
                for (int bj = 0; bj < 2; ++bj) { f32x4 v0 = acc[ai][bj][m][0] * rs, v1 = acc[ai][bj][m][1] * rs; u32x4 w;
                    w.x = cvt_pk_bf16(v0[0], v0[1]); w.y = cvt_pk_bf16(v0[2], v0[3]); w.z = cvt_pk_bf16(v1[0], v1[1]); w.w = cvt_pk_bf16(v1[2], v1[3]);
                    __builtin_nontemporal_store(w, (u32x4*)(rowp + bj * 32)); } }
            return;
        }
        const PG8_LAS float* nw = ltab + nidx * 64 + fq * 8; const PG8_LAS float* r16 = ltab + 256 + fq * 16;
        const int pos0 = (row0 < T_P) ? (row0 & (L_P - 1)) : (row0 & (L_S - 1));
        f32x4 tb[4];
#pragma unroll
        for (int i = 0; i < 4; ++i) tb[i] = *(const f32x4*)(rope + (size_t)pos0 * 32 + fq * 8 + 2 * i);
        f32x4 cc[2], sc[2];
#pragma unroll
        for (int n = 0; n < 2; ++n) { cc[n] = (f32x4){tb[2 * n][0], tb[2 * n][2], tb[2 * n + 1][0], tb[2 * n + 1][2]}; sc[n] = (f32x4){tb[2 * n][1], tb[2 * n][3], tb[2 * n + 1][1], tb[2 * n + 1][3]}; }
        const int hs = 4 * pn + wc, sh = (hs < 12) ? 0 : 2 * (((hs - 12) % 12) >> 2);
        bf16_t* qbase = QKV + ((size_t)hs * T_ALL + qh_tau(hs, row0)) * 64 + fq * 8;
#pragma unroll
        for (int ai = 0; ai < 2; ++ai) {
#pragma unroll
            for (int m = 0; m < 4; ++m) {
                f32x4 gw[2][2];
#pragma unroll
                for (int bj = 0; bj < 2; ++bj)
#pragma unroll
                    for (int n = 0; n < 2; ++n) gw[bj][n] = *(const PG8_LAS f32x4*)(nw + bj * 32 + n * 4);
                if (ai + m > 0) {
                    f32x4 t16[4], c16[2], s16[2];
#pragma unroll
                    for (int i = 0; i < 4; ++i) t16[i] = *(const PG8_LAS f32x4*)(r16 + 4 * i);
#pragma unroll
                    for (int n = 0; n < 2; ++n) { c16[n] = (f32x4){t16[2 * n][0], t16[2 * n][2], t16[2 * n + 1][0], t16[2 * n + 1][2]}; s16[n] = (f32x4){t16[2 * n][1], t16[2 * n][3], t16[2 * n + 1][1], t16[2 * n + 1][3]}; }
#pragma unroll
                    for (int rep = 0; rep < ((ai == 1 && m == 0) ? 5 : 1); ++rep)
#pragma unroll
                        for (int n = 0; n < 2; ++n) ROT4(cc[n], sc[n], c16[n], s16[n]); }
                const float rs = __builtin_amdgcn_rsqf(rsv[ai * 4 + m] * (1.0f / DM) + EPS) * oscale;
                f32x4 v[2][2]; float ssq = 0.f;
#pragma unroll
                for (int bj = 0; bj < 2; ++bj)
#pragma unroll
                    for (int n = 0; n < 2; ++n) { v[bj][n] = acc[ai][bj][m][n] * rs; ssq += (v[bj][n][0] * v[bj][n][0] + v[bj][n][1] * v[bj][n][1]) + (v[bj][n][2] * v[bj][n][2] + v[bj][n][3] * v[bj][n][3]); }
                ssq += SHFLX(ssq, 16); ssq += SHFLX(ssq, 32);
                const float r2 = __builtin_amdgcn_rsqf(ssq * (1.0f / 64.0f) + EPS);
#pragma unroll
                for (int bj = 0; bj < 2; ++bj)
#pragma unroll
                    for (int n = 0; n < 2; ++n) v[bj][n] = v[bj][n] * r2 * gw[bj][n];
                f32x4 olo[2], ohi[2];
#pragma unroll
                for (int n = 0; n < 2; ++n) { olo[n] = v[0][n] * cc[n] - v[1][n] * sc[n]; ohi[n] = v[1][n] * cc[n] + v[0][n] * sc[n]; }
                bf16_t* rowp = qbase + (size_t)((ai * HALF + m * 16) >> sh) * 64; u32x4 w;
                w.x = cvt_pk_bf16(olo[0][0], olo[0][1]); w.y = cvt_pk_bf16(olo[0][2], olo[0][3]); w.z = cvt_pk_bf16(olo[1][0], olo[1][1]); w.w = cvt_pk_bf16(olo[1][2], olo[1][3]);
                __builtin_nontemporal_store(w, (u32x4*)(rowp));
                w.x = cvt_pk_bf16(ohi[0][0], ohi[0][1]); w.y = cvt_pk_bf16(ohi[0][2], ohi[0][3]); w.z = cvt_pk_bf16(ohi[1][0], ohi[1][1]); w.w = cvt_pk_bf16(ohi[1][2], ohi[1][3]);
                __builtin_nontemporal_store(w, (u32x4*)(rowp + 32));
                asm volatile("" ::: "memory"); } }
    }
};

template <int SECOND> struct EpiBranch {
    static constexpr bool PERM = true, AFTER_DRAIN = false;
    bf16_t* G;
    __device__ __forceinline__ void operator()(const f32x4 (&acc)[2][2][4][2], const Unit& u, int wr, int wc, int, int) const {
        LANE_FRFQ;
        int row0 = u.pm * BM + wr * 64 + fr; asm volatile("" : "+v"(row0)); const int col0 = u.pn * BM + wc * 32 + 8 * fq;
        bf16_t* base = G + (size_t)row0 * NGATE + col0;
#pragma unroll
        for (int ai = 0; ai < 2; ++ai) {
            u32x4 gt[4][2], pv[4][2];
#pragma unroll
            for (int m = 0; m < 4; ++m)
#pragma unroll
                for (int bj = 0; bj < 2; ++bj) { const bf16_t* p = base + (size_t)(ai * HALF + m * 16) * NGATE + bj * HALF; gt[m][bj] = *(const u32x4*)(p + (SECOND ? DM : 0)); if (SECOND) pv[m][bj] = *(const u32x4*)p; }
#pragma unroll
            for (int m = 0; m < 4; ++m)
#pragma unroll
                for (int bj = 0; bj < 2; ++bj) { const f32x4 a0 = acc[ai][bj][m][0], a1 = acc[ai][bj][m][1]; const u32x4 g = gt[m][bj];
                    float o[8] = {a0[0] * bf_lo(g.x), a0[1] * bf_hi(g.x), a0[2] * bf_lo(g.y), a0[3] * bf_hi(g.y), a1[0] * bf_lo(g.z), a1[1] * bf_hi(g.z), a1[2] * bf_lo(g.w), a1[3] * bf_hi(g.w)};
                    if (SECOND) { const u32x4 q = pv[m][bj];
                        o[0] += bf_lo(q.x); o[1] += bf_hi(q.x); o[2] += bf_lo(q.y); o[3] += bf_hi(q.y); o[4] += bf_lo(q.z); o[5] += bf_hi(q.z); o[6] += bf_lo(q.w); o[7] += bf_hi(q.w); }
                    u32x4 w; w.x = cvt_pk_bf16(o[0], o[1]); w.y = cvt_pk_bf16(o[2], o[3]); w.z = cvt_pk_bf16(o[4], o[5]); w.w = cvt_pk_bf16(o[6], o[7]);
                    gt[m][bj] = w; }
#pragma unroll
            for (int m = 0; m < 4; ++m)
#pragma unroll
                for (int bj = 0; bj < 2; ++bj) *(u32x4*)(base + (size_t)(ai * HALF + m * 16) * NGATE + bj * HALF) = gt[m][bj];
        }
    }
};

struct EpiBranchFused {
    static constexpr bool PERM = true, AFTER_DRAIN = false;
    bf16_t* G; unsigned char* MIX8;
    __device__ __forceinline__ void mid(f32x4 (&acc)[2][2][4][2], const Unit& u, int wr, int wc, int, int) const {
        LANE_FRFQ;
        int row0 = u.pm * BM + wr * 64 + fr; asm volatile("" : "+v"(row0)); const int col0 = u.pn * BM + wc * 32 + 8 * fq;
        const bf16_t* base = G + (size_t)row0 * NGATE + col0;
#pragma unroll
        for (int ai = 0; ai < 2; ++ai) {
            u32x4 gr[4][2];
#pragma unroll
            for (int m = 0; m < 4; ++m)
#pragma unroll
                for (int bj = 0; bj < 2; ++bj) gr[m][bj] = *(const u32x4*)(base + (size_t)(ai * HALF + m * 16) * NGATE + bj * HALF);
#pragma unroll
            for (int m = 0; m < 4; ++m)
#pragma unroll
                for (int bj = 0; bj < 2; ++bj) { const u32x4 a = gr[m][bj];
                    acc[ai][bj][m][0] = acc[ai][bj][m][0] * (f32x4){bf_lo(a.x), bf_hi(a.x), bf_lo(a.y), bf_hi(a.y)};
                    acc[ai][bj][m][1] = acc[ai][bj][m][1] * (f32x4){bf_lo(a.z), bf_hi(a.z), bf_lo(a.w), bf_hi(a.w)}; }
        }
    }
    __device__ __forceinline__ void operator()(const f32x4 (&acc)[2][2][4][2], const Unit& u, int wr, int wc, int, int) const {
        LANE_FRFQ;
        int row0 = u.pm * BM + wr * 64 + fr; asm volatile("" : "+v"(row0)); const int col0 = u.pn * BM + wc * 32 + 8 * fq;
        const bf16_t* base = G + (size_t)row0 * NGATE + col0;
        u32x4 gb[2][4][2];
#pragma unroll
        for (int ai = 0; ai < 2; ++ai)
#pragma unroll
            for (int m = 0; m < 4; ++m)
#pragma unroll
                for (int bj = 0; bj < 2; ++bj) gb[ai][m][bj] = *(const u32x4*)(base + (size_t)(ai * HALF + m * 16) * NGATE + bj * HALF + DM);
#pragma unroll
        for (int ai = 0; ai < 2; ++ai)
#pragma unroll
            for (int m = 0; m < 4; ++m)
#pragma unroll
                for (int bj = 0; bj < 2; ++bj) { const f32x4 a0 = acc[ai][bj][m][0] * (MIX8_SCALE / (AO8_SCALE * WBR8_SCALE)), a1 = acc[ai][bj][m][1] * (MIX8_SCALE / (AO8_SCALE * WBR8_SCALE));   const u32x4 g = gb[ai][m][bj]; u32x2 w;
                    w.x = cvt_pk_fp8x4(a0[0] * bf_lo(g.x), a0[1] * bf_hi(g.x), a0[2] * bf_lo(g.y), a0[3] * bf_hi(g.y)); w.y = cvt_pk_fp8x4(a1[0] * bf_lo(g.z), a1[1] * bf_hi(g.z), a1[2] * bf_lo(g.w), a1[3] * bf_hi(g.w));
                    *(u32x2*)(MIX8 + (size_t)(row0 + ai * HALF + m * 16) * DM + col0 + bj * HALF) = w; }
    }
};

struct EpiOutProj {
    static constexpr bool PERM = false, AFTER_DRAIN = false;
    const float* xp; const float* xs; float* out; bf16_t* X1B; float* ss2; float oscale;
    __device__ __forceinline__ void operator()(const f32x4 (&acc)[2][2][4][2], const Unit& u, int wr, int wc, int, int) const {
        LANE_FRFQ;
        const int rowt = u.pm * BM; const float* xb = (rowt < T_P) ? xp + (size_t)rowt * DM : xs + (size_t)(rowt - T_P) * DM;
        int rl0 = wr * 64 + fr; asm volatile("" : "+v"(rl0)); const int col0 = u.pn * BM + wc * 32 + 4 * fq;
#pragma unroll
        for (int ai = 0; ai < 2; ++ai) {
            f32x4 xv[4][2][2];
#pragma unroll
            for (int m = 0; m < 4; ++m)
#pragma unroll
                for (int bj = 0; bj < 2; ++bj)
#pragma unroll
                    for (int n = 0; n < 2; ++n) xv[m][bj][n] = __builtin_nontemporal_load((const f32x4*)(xb + (size_t)(rl0 + ai * HALF + m * 16) * DM + col0 + bj * HALF + n * 16));
#pragma unroll
            for (int m = 0; m < 4; ++m) { const int rl = rl0 + ai * HALF + m * 16; const size_t goff = (size_t)(rowt + rl) * DM + col0; float s = 0.f;
#pragma unroll
                for (int bj = 0; bj < 2; ++bj)
#pragma unroll
                    for (int n = 0; n < 2; ++n) { const f32x4 o = xv[m][bj][n] + acc[ai][bj][m][n] * oscale;
                        u32x2 w; w.x = cvt_pk_bf16(o[0], o[1]); w.y = cvt_pk_bf16(o[2], o[3]);
                        *(u32x2*)(X1B + goff + bj * HALF + n * 16) = w; s += (o[0] * o[0] + o[1] * o[1]) + (o[2] * o[2] + o[3] * o[3]); }
                s += SHFLX(s, 16); s += SHFLX(s, 32);
                if (fq == 0) atomicAdd(ss2 + rowt + rl, s); }
        }
    }
};

struct EpiGateUp {
    static constexpr bool PERM = true, AFTER_DRAIN = false;
    bf16_t* ACT; const float* ss2;
    __device__ __forceinline__ void operator()(const f32x4 (&acc)[2][2][4][2], const Unit& u, int wr, int wc, int, int) const {
        LANE_FRFQ;
        int row0 = u.pm * BM + wr * 64 + fr; asm volatile("" : "+v"(row0)); const int col0 = u.pn * HALF + wc * 32 + 8 * fq;
        float rsv[8];
#pragma unroll
        for (int i = 0; i < 8; ++i) rsv[i] = ss2[row0 + (i >> 2) * HALF + (i & 3) * 16];
#pragma unroll
        for (int ai = 0; ai < 2; ++ai)
#pragma unroll
            for (int m = 0; m < 4; ++m) { const int row = row0 + ai * HALF + m * 16; const float rs = __builtin_amdgcn_rsqf(rsv[ai * 4 + m] * (1.0f / DM) + EPS);
                float o[8];
#pragma unroll
                for (int n = 0; n < 2; ++n)
#pragma unroll
                    for (int j = 0; j < 4; ++j) { const float g = acc[ai][0][m][n][j] * rs, up = acc[ai][1][m][n][j] * rs; o[4 * n + j] = g * fast_sigmoid(g) * up; }
                u32x4 w; w.x = cvt_pk_bf16(o[0], o[1]); w.y = cvt_pk_bf16(o[2], o[3]); w.z = cvt_pk_bf16(o[4], o[5]); w.w = cvt_pk_bf16(o[6], o[7]);
                __builtin_nontemporal_store(w, (u32x4*)(ACT + (size_t)row * DFF + col0)); }
    }
};

struct EpiDown {
    static constexpr bool PERM = false, AFTER_DRAIN = false;
    float* out; const bf16_t* X1B;
    __device__ __forceinline__ void operator()(const f32x4 (&acc)[2][2][4][2], const Unit& u, int wr, int wc, int, int) const {
        LANE_FRFQ;
        int row0 = u.pm * BM + wr * 64 + fr; asm volatile("" : "+v"(row0)); const int col0 = u.pn * BM + wc * 32 + 4 * fq;
        u32x2 xv[2][4][2][2];
#pragma unroll
        for (int ai = 0; ai < 2; ++ai)
#pragma unroll
            for (int m = 0; m < 4; ++m)
#pragma unroll
                for (int bj = 0; bj < 2; ++bj)
#pragma unroll
                    for (int n = 0; n < 2; ++n) xv[ai][m][bj][n] = *(const u32x2*)(X1B + (size_t)(row0 + ai * HALF + m * 16) * DM + col0 + bj * HALF + n * 16);
#pragma unroll
        for (int ai = 0; ai < 2; ++ai)
#pragma unroll
            for (int m = 0; m < 4; ++m)
#pragma unroll
                for (int bj = 0; bj < 2; ++bj)
#pragma unroll
                    for (int n = 0; n < 2; ++n) { const u32x2 w = xv[ai][m][bj][n]; const f32x4 a = acc[ai][bj][m][n];
                        __builtin_nontemporal_store((f32x4){bf_lo(w.x) + a[0], bf_hi(w.x) + a[1], bf_lo(w.y) + a[2], bf_hi(w.y) + a[3]}, (f32x4*)(out + (size_t)(row0 + ai * HALF + m * 16) * DM + col0 + bj * HALF + n * 16)); }
    }
};

template <class Epi, class Sched, bool ALIGN_EPI = false, bool SP2 = false, int HOOK_T = -1, bool FP8 = false>
__device__ __forceinline__ void gemm_phase(PG8_LAS unsigned char* lds, const Gemm g, const Sched& S, const Epi& E, const int wid) {
    int lane = lane_id(); asm volatile("" : "+v"(lane));
    const int tid = wid * 64 + lane, wr = wid >> 2, wc = wid & 3, fr = lane & 15, fq = lane >> 4;
    const int K = g.K, nt = K / BK;
    unsigned voffA[2], voffB[2];
#pragma unroll
    for (int i = 0; i < 2; ++i) { int R, C; stage_rc(tid * 16 + i * 8192, R, C); const int Rb = Epi::PERM ? ((R & ~31) + perm32(R & 31)) : R;
        voffA[i] = (unsigned)(R * g.lda + C) * 2u; voffB[i] = (unsigned)(Rb * g.ldb + C) * 2u; }
    const size_t kstep = (size_t)(BK * 2);
    const size_t hstepA = (size_t)HALF * g.lda * 2, hstepB = (size_t)HALF * g.ldb * 2;
    const size_t tstepA = 2 * hstepA, tstepB = 2 * hstepB;
    const unsigned ldsw = (unsigned)wid * 1024u;
    const int aoff = lds_byte(wr * 64 + fr, fq * 8), boff = lds_byte(wc * 32 + fr, fq * 8);
#define PG8_SA(b, h) (((b) * 2 + (h)) * HTB)
#define PG8_SB(b, h) ((4 + (b) * 2 + (h)) * HTB)
#define PG8_STAGE(bufoff, gbase, voff) do { _Pragma("unroll") for (int _i = 0; _i < 2; ++_i) \
        __builtin_amdgcn_global_load_lds((const unsigned*)((const char*)(gbase) + (voff)[_i]), (PG8_LAS unsigned*)(lds + (bufoff) + ldsw + _i * 8192), 16, 0, 0); } while (0)
#define PG8_LDA(dst, b, h) do { _Pragma("unroll") for (int m = 0; m < 4; ++m) _Pragma("unroll") for (int k = 0; k < 2; ++k) dst[m][k] = *(const PG8_LAS bf16x8*)(lds + PG8_SA(b, h) + aoff + m * 2048 + k * 1024); } while (0)
#define PG8_LDB(dst, b, h) do { _Pragma("unroll") for (int n = 0; n < 2; ++n) _Pragma("unroll") for (int k = 0; k < 2; ++k) dst[n][k] = *(const PG8_LAS bf16x8*)(lds + PG8_SB(b, h) + boff + n * 2048 + k * 1024); } while (0)
#define PG8_MMA(ai, bj, At, Bt) do { __builtin_amdgcn_s_setprio(1); if constexpr (FP8) { _Pragma("unroll") for (int m = 0; m < 4; ++m) _Pragma("unroll") for (int n = 0; n < 2; ++n) \
        asm volatile("v_mfma_f32_16x16x128_f8f6f4 %0, %1, %2, %0" : "+v"(acc[ai][bj][m][n]) : "v"(cat8(Bt[n][0], Bt[n][1])), "v"(cat8(At[m][0], At[m][1]))); } else { \
        _Pragma("unroll") for (int m = 0; m < 4; ++m) _Pragma("unroll") for (int n = 0; n < 2; ++n) _Pragma("unroll") for (int k = 0; k < 2; ++k) \
        acc[ai][bj][m][n] = __builtin_amdgcn_mfma_f32_16x16x32_bf16(Bt[n][k], At[m][k], acc[ai][bj][m][n], 0, 0, 0); } __builtin_amdgcn_s_setprio(0); } while (0)
#define PG8_WAIT_V(n) asm volatile("s_waitcnt vmcnt(" #n ")" ::: "memory")
#define PG8_WAIT_L(n) asm volatile("s_waitcnt lgkmcnt(" #n ")" ::: "memory")
#define PG8_BAR __builtin_amdgcn_s_barrier()
#define PG8_SCHED __builtin_amdgcn_sched_barrier(0)
    Unit cur, nxt; int ui = 0;
    if (!S.next(0, cur)) return;
    f32x4 acc[2][2][4][2];
#pragma unroll
    for (int a = 0; a < 2; ++a)
#pragma unroll
        for (int b = 0; b < 2; ++b)
#pragma unroll
            for (int m = 0; m < 4; ++m)
#pragma unroll
                for (int n = 0; n < 2; ++n) acc[a][b][m][n] = (f32x4){0.f, 0.f, 0.f, 0.f};
    bf16x8 At[4][2], B0[2][2], B1[2][2];
    const char* cA = (const char*)g.A + (size_t)cur.pm * tstepA; const char* cB = (const char*)g.Bt + (size_t)cur.pn * tstepB;
    S.a_ready(cur);
    if constexpr (SP2) {
        PG8_STAGE(PG8_SB(0, 0), cB, voffB); PG8_STAGE(PG8_SB(0, 1), cB + hstepB, voffB); PG8_STAGE(PG8_SA(0, 0), cA, voffA); PG8_STAGE(PG8_SA(0, 1), cA + hstepA, voffA);
        if (wr == 1) PG8_BAR;
        PG8_WAIT_V(2); PG8_BAR;
        PG8_STAGE(PG8_SB(1, 0), cB + kstep, voffB); PG8_STAGE(PG8_SA(1, 0), cA + kstep, voffA); PG8_STAGE(PG8_SB(1, 1), cB + hstepB + kstep, voffB);
        PG8_WAIT_V(6); PG8_BAR;
    } else {
        PG8_STAGE(PG8_SB(0, 0), cB, voffB); PG8_STAGE(PG8_SA(0, 0), cA, voffA); PG8_STAGE(PG8_SB(0, 1), cB + hstepB, voffB); PG8_STAGE(PG8_SA(0, 1), cA + hstepA, voffA);
        if (wr == 1) PG8_BAR;
        PG8_WAIT_V(4); PG8_BAR;
        PG8_STAGE(PG8_SB(1, 0), cB + kstep, voffB); PG8_STAGE(PG8_SA(1, 0), cA + kstep, voffA); PG8_STAGE(PG8_SB(1, 1), cB + hstepB + kstep, voffB);
        PG8_WAIT_V(6); PG8_BAR;
    }
    for (;;) {
        const bool has_next = S.next(ui + 1, nxt);
        const char* nA = has_next ? (const char*)g.A + (size_t)nxt.pm * tstepA : cA; const char* nB = has_next ? (const char*)g.Bt + (size_t)nxt.pn * tstepB : cB;
#pragma clang loop unroll(disable)
        for (int t = 0; t < nt; t += 2) {
            if constexpr (HOOK_T >= 0) { if (t == HOOK_T) { if constexpr (FP8) asm volatile("s_nop 15\n\ts_nop 7" ::: "memory"); E.mid(acc, cur, wr, wc, fr, fq); } }
            const bool last = (t == nt - 2);
            const char* a1 = cA + (size_t)(t + 1) * kstep;
            const char* a2 = last ? nA : cA + (size_t)(t + 2) * kstep; const char* b2 = last ? nB : cB + (size_t)(t + 2) * kstep;
            const char* a3 = a2 + kstep; const char* b3 = b2 + kstep;
            if (last && has_next) S.a_ready(nxt);
            if constexpr (SP2) {
            PG8_LDB(B0, 0, 0); PG8_LDB(B1, 0, 1); PG8_SCHED; PG8_LDA(At, 0, 0); PG8_STAGE(PG8_SA(1, 1), a1 + hstepA, voffA);
            PG8_WAIT_V(8); PG8_WAIT_L(0); PG8_BAR; PG8_MMA(0, 0, At, B0); PG8_MMA(0, 1, At, B1); PG8_BAR; PG8_SCHED;
            PG8_LDA(At, 0, 1); PG8_STAGE(PG8_SB(0, 0), b2, voffB); PG8_STAGE(PG8_SB(0, 1), b2 + hstepB, voffB); PG8_STAGE(PG8_SA(0, 0), a2, voffA);
            PG8_WAIT_V(8); PG8_WAIT_L(0); PG8_BAR; PG8_MMA(1, 0, At, B0); PG8_MMA(1, 1, At, B1); PG8_BAR; PG8_SCHED;
            PG8_LDB(B0, 1, 0); PG8_LDB(B1, 1, 1); PG8_SCHED; PG8_LDA(At, 1, 0); PG8_STAGE(PG8_SA(0, 1), a2 + hstepA, voffA);
            PG8_WAIT_V(8); PG8_WAIT_L(0); PG8_BAR; PG8_MMA(0, 0, At, B0); PG8_MMA(0, 1, At, B1); PG8_BAR; PG8_SCHED;
            PG8_LDA(At, 1, 1); PG8_STAGE(PG8_SB(1, 0), b3, voffB); PG8_STAGE(PG8_SB(1, 1), b3 + hstepB, voffB); PG8_STAGE(PG8_SA(1, 0), a3, voffA);
            PG8_WAIT_V(8); PG8_WAIT_L(0); PG8_BAR; PG8_MMA(1, 0, At, B0); PG8_MMA(1, 1, At, B1); PG8_BAR; PG8_SCHED;
            } else {
            PG8_LDB(B0, 0, 0); PG8_SCHED; PG8_LDA(At, 0, 0); PG8_STAGE(PG8_SA(1, 1), a1 + hstepA, voffA);
            PG8_WAIT_L(8); PG8_BAR; PG8_WAIT_L(0); PG8_MMA(0, 0, At, B0); PG8_BAR; PG8_SCHED;
            PG8_LDB(B1, 0, 1); PG8_STAGE(PG8_SB(0, 0), b2, voffB);
            PG8_BAR; PG8_WAIT_L(0); PG8_MMA(0, 1, At, B1); PG8_BAR;
            PG8_LDA(At, 0, 1); PG8_STAGE(PG8_SA(0, 0), a2, voffA);
            PG8_BAR; PG8_WAIT_L(0); PG8_MMA(1, 0, At, B0); PG8_BAR; PG8_SCHED;
            PG8_STAGE(PG8_SB(0, 1), b2 + hstepB, voffB);
            PG8_WAIT_V(6); PG8_BAR; PG8_MMA(1, 1, At, B1); PG8_BAR;
            PG8_LDB(B0, 1, 0); PG8_SCHED; PG8_LDA(At, 1, 0); PG8_STAGE(PG8_SA(0, 1), a2 + hstepA, voffA);
            PG8_WAIT_L(8); PG8_BAR; PG8_WAIT_L(0); PG8_MMA(0, 0, At, B0); PG8_BAR; PG8_SCHED;
            PG8_LDB(B1, 1, 1); PG8_STAGE(PG8_SB(1, 0), b3, voffB);
            PG8_BAR; PG8_WAIT_L(0); PG8_MMA(0, 1, At, B1); PG8_BAR;
            PG8_LDA(At, 1, 1); PG8_STAGE(PG8_SA(1, 0), a3, voffA);
            PG8_BAR; PG8_WAIT_L(0); PG8_MMA(1, 0, At, B0); PG8_BAR; PG8_SCHED;
            PG8_STAGE(PG8_SB(1, 1), b3 + hstepB, voffB);
            PG8_WAIT_V(6); PG8_BAR; PG8_MMA(1, 1, At, B1); PG8_BAR;
            }
        }
        if constexpr (ALIGN_EPI) { if (wr == 0) PG8_BAR; }
        if constexpr (FP8) asm volatile("s_nop 15\n\ts_nop 7" ::: "memory");
        if constexpr (!Epi::AFTER_DRAIN) { E(acc, cur, wr, wc, fr, fq); S.done(cur); }
        if (!has_next) break;
#pragma unroll
        for (int a = 0; a < 2; ++a)
#pragma unroll
            for (int b = 0; b < 2; ++b)
#pragma unroll
                for (int m = 0; m < 4; ++m)
#pragma unroll
                    for (int n = 0; n < 2; ++n) acc[a][b][m][n] = (f32x4){0.f, 0.f, 0.f, 0.f};
        cur = nxt; cA = nA; cB = nB; ++ui;
        if constexpr (ALIGN_EPI) { if (wr == 1) PG8_BAR; }
    }
    PG8_WAIT_V(0);
    if constexpr (!ALIGN_EPI) { if (wr == 0) PG8_BAR; }
    PG8_BAR;
    if constexpr (Epi::AFTER_DRAIN) { E.fused(acc, cur, wr, wc, fr, fq, lds, wid, lane); S.done(cur); }
#undef PG8_SA
#undef PG8_SB
#undef PG8_STAGE
#undef PG8_LDA
#undef PG8_LDB
#undef PG8_MMA
#undef PG8_WAIT_V
#undef PG8_WAIT_L
#undef PG8_BAR
#undef PG8_SCHED
}
}

using namespace pg8;
#define LAS __attribute__((address_space(3)))
typedef float f32x16 __attribute__((ext_vector_type(16)));
typedef short s16x4 __attribute__((ext_vector_type(4)));
typedef short v4i16_t __attribute__((ext_vector_type(4)));

constexpr size_t MiB = 1u << 20;
constexpr size_t WS_SS1 = 0, WS_SS2 = 512 * 1024, WS_NORMT = 960 * 1024, WS_BAR = 992 * 1024;
constexpr size_t WS_ROPE = 1 * MiB;
constexpr size_t WS_LB = 5 * MiB;
constexpr size_t WS_WIN = 10 * MiB, WS_WBR = 20 * MiB, WS_WOUT = 22 * MiB, WS_WGU = 24 * MiB, WS_WD = 35 * MiB;
constexpr size_t WS_QKV = 42 * MiB;
constexpr size_t WS_G = 618 * MiB;
constexpr size_t WS_END = 1002 * MiB;
constexpr size_t WS_X1B = WS_QKV, WS_ACT = WS_QKV + 192 * MiB;
static_assert(WS_ACT + (size_t)T_ALL * DFF * 2 <= WS_END, "ws map");

constexpr int LDS_BYTES = 147456;
constexpr int AT_K = 0, AT_V = 49152, AT_WS = 98304, AT_OST = 100352;

__device__ __forceinline__ float wave_sum(float v) {
#pragma unroll
    for (int o = 1; o < 64; o <<= 1) v += __shfl_xor(v, o);
    return v;
}
__device__ __forceinline__ float wave_max(float v) {
#pragma unroll
    for (int o = 1; o < 64; o <<= 1) v = fmaxf(v, __shfl_xor(v, o));
    return v;
}

template <bool F8 = false>
__device__ __forceinline__ void transpose_item(const float* W, int N, bf16_t* WT, int ldw, int kcol, const float* kscale, int mode, LAS float* scr, int item, int lane, float mul = 1.0f) {
    const int nblk = N / 32, kb = item / nblk, nb = item % nblk, k0 = 64 * kb, n0 = 32 * nb;
    float wv[32], ks[32];
#pragma unroll
    for (int i = 0; i < 32; ++i) { const int kk = 2 * i + (lane >> 5); wv[i] = W[(size_t)(k0 + kk) * N + n0 + (lane & 31)]; ks[i] = kscale ? kscale[k0 + kk] : 1.0f; }
#pragma unroll
    for (int i = 0; i < 32; ++i) { const int kk = 2 * i + (lane >> 5); scr[kk * 33 + (lane & 31)] = wv[i] * ks[i] * mul; }
    asm volatile("s_waitcnt lgkmcnt(0)" ::: "memory");
    int rb;
    if (mode == 1) { if (n0 < NQKV) { const int np = n0 & 255; rb = (n0 & ~255) + 128 * ((np >> 5) & 1) + 32 * (np >> 6); }
                     else { const int c = n0 - NQKV, cc = c & 1023; rb = NQKV + (cc >> 7) * 256 + (c >> 10) * 128 + (cc & 127); } }
    else if (mode == 2) rb = (n0 >> 7) * 256 + (n0 & 127);
    else if (mode == 3) rb = (n0 >> 7) * 256 + 128 + (n0 & 127);
    else rb = n0;
    const int c = lane & 7;
#pragma unroll
    for (int j = 0; j < 4; ++j) { const int n = (lane >> 3) + 8 * j; const LAS float* s = scr + (8 * c) * 33 + n;
        if constexpr (F8) { u32x2 o; o.x = cvt_pk_fp8x4(s[0 * 33], s[1 * 33], s[2 * 33], s[3 * 33]); o.y = cvt_pk_fp8x4(s[4 * 33], s[5 * 33], s[6 * 33], s[7 * 33]);
            *(u32x2*)((unsigned char*)WT + (size_t)(rb + n) * ldw + kcol + k0 + 8 * c) = o; }
        else { u32x4 o; o.x = cvt_pk_bf16(s[0 * 33], s[1 * 33]); o.y = cvt_pk_bf16(s[2 * 33], s[3 * 33]); o.z = cvt_pk_bf16(s[4 * 33], s[5 * 33]); o.w = cvt_pk_bf16(s[6 * 33], s[7 * 33]);
            *(u32x4*)(WT + (size_t)(rb + n) * ldw + kcol + k0 + 8 * c) = o; } }
    asm volatile("s_waitcnt lgkmcnt(0)" ::: "memory");
}

#define XB_TMO      128
#define XB_XCNT(j)  (256  + 64 * (j))
#define XB_XSUB(j)  (1280 + 64 * (j))
#define XB_XGEN(j)  (2304 + 64 * (j))
#define XB_TOP      3328
#define XB_TOPGEN   3392
#define XCD_BAR_WORDS 3456
#define XB_SPIN_CAP (1u << 18)

__device__ __forceinline__ unsigned xb_ld(unsigned* p)              { return __hip_atomic_load(p, __ATOMIC_RELAXED, __HIP_MEMORY_SCOPE_AGENT); }
__device__ __forceinline__ unsigned xb_add(unsigned* p, unsigned v) { return __hip_atomic_fetch_add(p, v, __ATOMIC_RELAXED, __HIP_MEMORY_SCOPE_AGENT); }
__device__ __forceinline__ unsigned xb_xcc_id() { return (unsigned)__builtin_amdgcn_s_getreg((3 << 11) | 20) & 0xFu; }
#define XB_SPIN(cond, bar) do { unsigned _sp = 0; while (cond) { __builtin_amdgcn_s_sleep(1); \
    if ((++_sp & 255u) == 0u) { if (xb_ld(&(bar)[XB_TMO])) break; if (_sp > XB_SPIN_CAP) { atomicAdd(&(bar)[XB_TMO], 1u); break; } } } } while (0)

struct XcdBarrier {
    unsigned* bar; unsigned x;
    volatile LAS unsigned* st;
};

__device__ __forceinline__ XcdBarrier xcd_barrier_post(unsigned* bar, volatile LAS unsigned* st, bool leader) {
    XcdBarrier b; b.bar = bar; b.x = xb_xcc_id(); b.st = st;
    if (leader) (void)xb_add(&bar[XB_XCNT(b.x)], 1u);
    return b;
}
__device__ __forceinline__ void xcd_barrier_complete(unsigned* bar, unsigned x, unsigned& nloc, unsigned& nx) {
    const unsigned G = gridDim.x * gridDim.y * gridDim.z;
    unsigned sum, cnt, mine, sp = 0u;
    for (;;) {
        sum = 0u; cnt = 0u; mine = 0u;
#pragma unroll
        for (unsigned j = 0; j < 16; ++j) { const unsigned c = xb_ld(&bar[XB_XCNT(j)]); sum += c; cnt += (c > 0u) ? 1u : 0u; mine = (j == x) ? c : mine; }
        if (sum == G) break;
        __builtin_amdgcn_s_sleep(1);
        if ((++sp & 255u) == 0u) { if (xb_ld(&bar[XB_TMO])) break; if (sp > XB_SPIN_CAP) { atomicAdd(&bar[XB_TMO], 1u); break; } }
    }
    nloc = mine > 0u ? mine : 1u; nx = cnt > 0u ? cnt : 1u;
}

__device__ __forceinline__ void xcd_barrier(const XcdBarrier& b, bool leader) {
    asm volatile("s_waitcnt vmcnt(0)" ::: "memory");
    __syncthreads();
    if (leader) {
        unsigned* bar = b.bar;
        __builtin_amdgcn_s_waitcnt(0);
        unsigned nloc = b.st[0], nx = b.st[1];
        if (nloc == 0u) { xcd_barrier_complete(bar, b.x, nloc, nx); b.st[0] = nloc; b.st[1] = nx; }
        const unsigned old = xb_add(&bar[XB_XSUB(b.x)], 1u);
        const unsigned gen = old / nloc;
        if (old + 1u == (gen + 1u) * nloc) {
            __builtin_amdgcn_fence(__ATOMIC_RELEASE, "agent");
            asm volatile("s_waitcnt vmcnt(0)" ::: "memory");
            const unsigned og = xb_add(&bar[XB_TOP], 1u);
            const unsigned tg = og / nx;
            if (og + 1u == (tg + 1u) * nx) xb_add(&bar[XB_TOPGEN], 1u);
            else XB_SPIN(xb_ld(&bar[XB_TOPGEN]) == tg, bar);
            __builtin_amdgcn_fence(__ATOMIC_ACQUIRE, "agent");
            xb_add(&bar[XB_XGEN(b.x)], 1u);
            asm volatile("s_waitcnt vmcnt(0)" ::: "memory");
        } else {
            XB_SPIN(xb_ld(&bar[XB_XGEN(b.x)]) == gen, bar);
            __builtin_amdgcn_fence(__ATOMIC_ACQUIRE, "agent");
            asm volatile("s_waitcnt vmcnt(0)" ::: "memory");
        }
    }
    __syncthreads();
}


struct Args {
    const float *x_prompt, *x_sample, *norm1, *w_in, *qn_a, *kn_a, *sink_a, *qn_b, *kn_b, *w_br_a, *w_br_b, *w_out, *norm2, *w_gate, *w_up, *w_down;
    float* out; unsigned char* ws;
    float inv_freq[32];
    int ph_lo, ph_hi;
};

__device__ __forceinline__ void p0_prologue(const Args& a, LAS unsigned char* lds, int vcu, int G, const int wave) {
    int lane = lane_id(); asm volatile("" : "+v"(lane));
    unsigned char* ws = a.ws;
    const int gtid = vcu * 512 + wave * 64 + lane, NT = G * 512;
    float* ss1 = (float*)(ws + WS_SS1); float* ss2 = (float*)(ws + WS_SS2);
    for (int i = gtid; i < T_ALL; i += NT) ss2[i] = 0.f;
    if (gtid < 256) { const int w = gtid >> 6, c = gtid & 63; ((float*)(ws + WS_NORMT))[gtid] = (w == 0) ? a.qn_a[c] : (w == 1) ? a.kn_a[c] : (w == 2) ? a.qn_b[c] : a.kn_b[c]; }
    f32x2* rope = (f32x2*)(ws + WS_ROPE);
    for (int i = gtid; i < 16384 * 32; i += NT) { const int pos = i >> 5, c = i & 31; const float ang = (float)pos * a.inv_freq[c];
        double rev = (double)ang * 0.15915494309189535; rev -= floor(rev); const float fr = (float)rev;
        rope[i] = (f32x2){__builtin_amdgcn_cosf(fr), __builtin_amdgcn_sinf(fr)}; }
    LAS float* scr = (LAS float*)(lds + wave * 16384);
    const int gw = vcu * 8 + wave, NGW = G * 8;
    constexpr int I_IN = (DM / 64) * (NIN / 32), I_BA = (512 / 64) * (DM / 32), I_BB = (256 / 64) * (DM / 32), I_OUT = (DM / 64) * (DM / 32), I_G = (DM / 64) * (DFF / 32), I_D = (DFF / 64) * (DM / 32);
    constexpr int NITEMS = I_IN + I_BA + I_BB + I_OUT + 2 * I_G + I_D;
    bf16_t* WinT = (bf16_t*)(ws + WS_WIN); bf16_t* WbrT = (bf16_t*)(ws + WS_WBR); bf16_t* WoutT = (bf16_t*)(ws + WS_WOUT); bf16_t* WguT = (bf16_t*)(ws + WS_WGU); bf16_t* WdT = (bf16_t*)(ws + WS_WD);
    for (int it = gw; it < NITEMS; it += NGW) {
        int r = it;
        if (r < I_IN) { transpose_item<true>(a.w_in, NIN, WinT, DM, 0, a.norm1, 1, scr, r, lane, W8_SCALE); continue; } r -= I_IN;
        if (r < I_BA) { transpose_item<true>(a.w_br_a, DM, WbrT, KBR, 0, nullptr, 0, scr, r, lane, WBR8_SCALE); continue; } r -= I_BA;
        if (r < I_BB) { transpose_item<true>(a.w_br_b, DM, WbrT, KBR, 512, nullptr, 0, scr, r, lane, WBR8_SCALE); continue; } r -= I_BB;
        if (r < I_OUT) { transpose_item<true>(a.w_out, DM, WoutT, DM, 0, nullptr, 0, scr, r, lane, W8_SCALE); continue; } r -= I_OUT;
        if (r < I_G) { transpose_item(a.w_gate, DFF, WguT, DM, 0, a.norm2, 2, scr, r, lane); continue; } r -= I_G;
        if (r < I_G) { transpose_item(a.w_up, DFF, WguT, DM, 0, a.norm2, 3, scr, r, lane); continue; } r -= I_G;
        transpose_item(a.w_down, DM, WdT, DFF, 0, nullptr, 0, scr, r, lane);
    }
    bf16_t* XB = (bf16_t*)a.out;
    for (int m0 = gw; m0 < T_ALL; m0 += 4 * NGW) {
        f32x4 v[4][4]; float s[4] = {0.f, 0.f, 0.f, 0.f};
#pragma unroll
        for (int k = 0; k < 4; ++k) { const int m = (m0 + k * NGW < T_ALL) ? m0 + k * NGW : m0;
            const float* xrow = (m < T_P) ? a.x_prompt + (size_t)m * DM : a.x_sample + (size_t)(m - T_P) * DM; const f32x4* xr = (const f32x4*)xrow + lane;
#pragma unroll
            for (int j = 0; j < 4; ++j) v[k][j] = __builtin_nontemporal_load(&xr[64 * j]); }
#pragma unroll
        for (int k = 0; k < 4; ++k)
#pragma unroll
            for (int j = 0; j < 4; ++j) s[k] += (v[k][j][0] * v[k][j][0] + v[k][j][1] * v[k][j][1]) + (v[k][j][2] * v[k][j][2] + v[k][j][3] * v[k][j][3]);
#pragma unroll
        for (int k = 0; k < 4; ++k) s[k] = wave_sum(s[k]);
#pragma unroll
        for (int k = 0; k < 4; ++k) { const int m = m0 + k * NGW; if (m >= T_ALL) break;
            unsigned* o4 = (unsigned*)((unsigned char*)XB + (size_t)m * DM) + lane;
#pragma unroll
            for (int j = 0; j < 4; ++j) o4[64 * j] = cvt_pk_fp8x4(v[k][j][0] * X8_SCALE, v[k][j][1] * X8_SCALE, v[k][j][2] * X8_SCALE, v[k][j][3] * X8_SCALE);
            if (lane == 0) ss1[m] = s[k]; }
    }
}

__device__ __forceinline__ int crow(int r, int hi) { return (r & 3) + 8 * (r >> 2) + 4 * hi; }
struct AUnit { size_t row0, qb, kb, vb; int dstr, res, Lf, ocol, jq0, jk0, t_lo, lbcol, slot0; float sink2; };

template <int NTL> __device__ __forceinline__ void at_issue(const bf16_t* QKV, const AUnit& u, int tid, u32x4 (&kreg)[NTL], u32x4 (&vreg)[NTL], bf16x8 (&qr)[4]) {
    const int row = tid >> 3, c = tid & 7, lane = tid & 63, r32 = lane & 31, hi = lane >> 5;
#pragma unroll
    for (int t = 0; t < NTL; ++t) { int j = u.jk0 + 64 * t + row; j = j < 0 ? 0 : (j >= u.Lf ? u.Lf - 1 : j); const size_t off = (size_t)j * 64 + c * 8;
        kreg[t] = *(const u32x4*)(QKV + u.kb + off); vreg[t] = *(const u32x4*)(QKV + u.vb + off); }
    const bf16_t* qp = QKV + u.qb + (size_t)(u.jq0 + r32) * 64 + hi * 8;
#pragma unroll
    for (int d0 = 0; d0 < 4; ++d0) qr[d0] = *(const bf16x8*)(qp + d0 * 16);
}
template <int NTL> __device__ __forceinline__ void at_stage(LAS unsigned char* lds, int tid, const u32x4 (&kreg)[NTL], const u32x4 (&vreg)[NTL]) {
    const int row = tid >> 3, c = tid & 7;
    LAS unsigned char* kd = lds + AT_K + c * 1024 + ((row & ~7) | ((row ^ c) & 7)) * 16;
    LAS unsigned char* vd = lds + AT_V + ((c >> 2) * 4 + (row >> 4)) * 1024 + (row & 15) * 64 + (c & 3) * 16;
#pragma unroll
    for (int t = 0; t < NTL; ++t) { *(LAS u32x4*)(kd + t * 8192) = kreg[t]; *(LAS u32x4*)(vd + t * 8192) = vreg[t]; }
}
template <int MODE> __device__ __forceinline__ void at_softmax(f32x16& p0, f32x16& p1, float& lsum, u32x4 (&pw)[4], int dW, int kb, unsigned W2, unsigned Lf) {
#pragma unroll
    for (int r = 0; r < 16; ++r) { const int c0 = (r & 3) + 8 * (r >> 2);
        float e0 = __builtin_amdgcn_exp2f(p0[r]), e1 = __builtin_amdgcn_exp2f(p1[r]);
        if (MODE >= 1) { bool v0 = (unsigned)(dW + c0) <= W2, v1 = (unsigned)(dW + c0 + 32) <= W2;
            if (MODE == 2) { v0 = v0 && ((unsigned)(kb + c0) < Lf); v1 = v1 && ((unsigned)(kb + c0 + 32) < Lf); }
            e0 = v0 ? e0 : 0.f; e1 = v1 ? e1 : 0.f; }
        p0[r] = e0; p1[r] = e1; lsum += e0 + e1; }
#pragma unroll
    for (int i = 0; i < 4; ++i) { pw[0][i] = cvt_pk_bf16(p0[2 * i], p0[2 * i + 1]); pw[1][i] = cvt_pk_bf16(p0[8 + 2 * i], p0[9 + 2 * i]); pw[2][i] = cvt_pk_bf16(p1[2 * i], p1[2 * i + 1]); pw[3][i] = cvt_pk_bf16(p1[8 + 2 * i], p1[9 + 2 * i]); }
}
#define AT_SBAR() __builtin_amdgcn_sched_barrier(0)
#define AT_LOADK(sl_) do { const LAS unsigned char* kp_ = kp0 + (sl_) * 8192; _Pragma("unroll") for (int d0 = 0; d0 < 4; ++d0) { kf[2 * d0] = *(const LAS bf16x8*)(kp_ + koff[d0]); kf[2 * d0 + 1] = *(const LAS bf16x8*)(kp_ + koff[d0] + 512); } } while (0)
template <int NTW, bool IS_A>
__device__ __forceinline__ void at_compute(LAS unsigned char* lds, bf16_t* OUT, float* LB, const AUnit& u, const bf16x8 (&qr)[4], int W, int lane, int wave) {
    const int r32 = lane & 31, hi = lane >> 5;
    f32x16 o[2], zero; float lsum = 0.f;
#pragma unroll
    for (int r = 0; r < 16; ++r) { o[0][r] = 0.f; o[1][r] = 0.f; zero[r] = 0.f; }
    const int qj = u.jq0 + r32;
    const LAS unsigned char* kp0 = lds + AT_K;
    int koff[4];
#pragma unroll
    for (int d0 = 0; d0 < 4; ++d0) { const int ch = 2 * d0 + hi; koff[d0] = ch * 1024 + ((r32 & ~7) | ((r32 ^ ch) & 7)) * 16; }
    const LAS unsigned char* vp0 = lds + AT_V + ((lane >> 4) & 1) * 32 + (lane & 3) * 8 + (4 * hi + ((lane & 15) >> 2)) * 64;
#pragma unroll 1
    for (int tt = 0; tt < NTW; ++tt) { const int t = u.t_lo + tt; const int tlo = u.jk0 + 64 * t;
        const bool edge = IS_A ? (tt == 0 || tt == NTW - 1) : (tt != 1);
        const bool inside = (tlo >= 0) && (tlo + 64 <= u.Lf);
        const int kb = tlo + 4 * hi, dW = kb - qj + W;
        int sl = u.slot0 + t; sl = sl >= 6 ? sl - 6 : sl;
        const LAS unsigned char* vp = vp0 + sl * 8192;
        bf16x8 kf[8]; AT_LOADK(sl);
        s16x4 vlo[4], vhi[4], wlo[4], whi[4];
#pragma unroll
        for (int i = 0; i < 4; ++i) { vlo[i] = __builtin_bit_cast(s16x4, __builtin_amdgcn_ds_read_tr16_b64_v4i16((LAS v4i16_t*)(vp + i * 1024)));
            vhi[i] = __builtin_bit_cast(s16x4, __builtin_amdgcn_ds_read_tr16_b64_v4i16((LAS v4i16_t*)(vp + i * 1024 + 512))); }
        AT_SBAR();
        f32x16 p0 = __builtin_amdgcn_mfma_f32_32x32x16_bf16(kf[0], qr[0], zero, 0, 0, 0), p1 = __builtin_amdgcn_mfma_f32_32x32x16_bf16(kf[1], qr[0], zero, 0, 0, 0);
#pragma unroll
        for (int d0 = 1; d0 < 4; ++d0) { p0 = __builtin_amdgcn_mfma_f32_32x32x16_bf16(kf[2 * d0], qr[d0], p0, 0, 0, 0); p1 = __builtin_amdgcn_mfma_f32_32x32x16_bf16(kf[2 * d0 + 1], qr[d0], p1, 0, 0, 0); }
        AT_SBAR();
        u32x4 pw[4];
        if (!inside) at_softmax<2>(p0, p1, lsum, pw, dW, kb, (unsigned)(2 * W), (unsigned)u.Lf);
        else if (edge) at_softmax<1>(p0, p1, lsum, pw, dW, kb, (unsigned)(2 * W), (unsigned)u.Lf);
        else at_softmax<0>(p0, p1, lsum, pw, dW, kb, (unsigned)(2 * W), (unsigned)u.Lf);
#pragma unroll
        for (int i = 0; i < 4; ++i) { wlo[i] = __builtin_bit_cast(s16x4, __builtin_amdgcn_ds_read_tr16_b64_v4i16((LAS v4i16_t*)(vp + 4096 + i * 1024)));
            whi[i] = __builtin_bit_cast(s16x4, __builtin_amdgcn_ds_read_tr16_b64_v4i16((LAS v4i16_t*)(vp + 4096 + i * 1024 + 512))); }
        AT_SBAR();
#pragma unroll
        for (int ks = 0; ks < 4; ++ks) { const bf16x8 vf = (bf16x8){vlo[ks][0], vlo[ks][1], vlo[ks][2], vlo[ks][3], vhi[ks][0], vhi[ks][1], vhi[ks][2], vhi[ks][3]};
            o[0] = __builtin_amdgcn_mfma_f32_32x32x16_bf16(__builtin_bit_cast(bf16x8, pw[ks]), vf, o[0], 0, 0, 0); }
#pragma unroll
        for (int ks = 0; ks < 4; ++ks) { const bf16x8 vf = (bf16x8){wlo[ks][0], wlo[ks][1], wlo[ks][2], wlo[ks][3], whi[ks][0], whi[ks][1], whi[ks][2], whi[ks][3]};
            o[1] = __builtin_amdgcn_mfma_f32_32x32x16_bf16(__builtin_bit_cast(bf16x8, pw[ks]), vf, o[1], 0, 0, 0); }
    }
    lsum += __shfl_xor(lsum, 32);
    LAS float* wsf = (LAS float*)(lds + AT_WS) + wave * 64;
    LAS bf16_t* stg = (LAS bf16_t*)(lds + AT_OST) + wave * 2048;
    if (IS_A) { lsum += __builtin_amdgcn_exp2f(u.sink2); if (hi == 0) wsf[r32] = __builtin_amdgcn_rcpf(lsum) * AO8_SCALE; }
    else { if (hi == 0) LB[(u.row0 + (size_t)(u.jq0 + r32) * u.dstr + u.res) * 12 + u.lbcol] = lsum; }
    asm volatile("s_waitcnt lgkmcnt(0)" ::: "memory");
    if (IS_A) {
        LAS unsigned char* st8 = (LAS unsigned char*)stg;
#pragma unroll
        for (int r = 0; r < 16; ++r) { const int orow = crow(r, hi); const float sc = wsf[orow];
            const unsigned w = (unsigned)__builtin_amdgcn_cvt_pk_fp8_f32(o[0][r] * sc, o[1][r] * sc, 0, false);
            st8[orow * 64 + r32] = (unsigned char)(w & 0xffu); st8[orow * 64 + 32 + r32] = (unsigned char)((w >> 8) & 0xffu); }
        asm volatile("s_waitcnt lgkmcnt(0)" ::: "memory");
#pragma unroll
        for (int i = 0; i < 2; ++i) { const int row = i * 16 + (lane >> 2), ch = lane & 3; const u32x4 v = *(const LAS u32x4*)(st8 + row * 64 + ch * 16);
            *(u32x4*)((unsigned char*)OUT + (u.row0 + (size_t)(u.jq0 + row)) * KBR + u.ocol + ch * 16) = v; }
    } else {
#pragma unroll
        for (int r = 0; r < 16; ++r) { const int orow = crow(r, hi);
#pragma unroll
            for (int d0 = 0; d0 < 2; ++d0) { const unsigned w = cvt_pk_bf16(o[d0][r], 0.f); stg[orow * 64 + d0 * 32 + r32] = (bf16_t)(w & 0xffffu); } }
        asm volatile("s_waitcnt lgkmcnt(0)" ::: "memory");
#pragma unroll
        for (int i = 0; i < 4; ++i) { const int row = i * 8 + (lane >> 3), ch = lane & 7; const u32x4 v = *(const LAS u32x4*)(stg + row * 64 + ch * 8);
            __builtin_nontemporal_store(v, (u32x4*)(OUT + (u.row0 + (size_t)(u.jq0 + row) * u.dstr + u.res) * KBR + u.ocol + ch * 8)); }
    }
}

__device__ __forceinline__ AUnit unit_a(int u, int wave, const float* sink_a, float) {
    AUnit d; const int kvh = u / (T_ALL / 64), qt = u % (T_ALL / 64); const int tok0 = qt * 64; int L;
    d.slot0 = (qt + 4) % 6;
    if (tok0 < T_P) { d.row0 = (size_t)(tok0 & ~(L_P - 1)); L = L_P; } else { d.row0 = (size_t)(tok0 & ~(L_S - 1)); L = L_S; }
    const int q0 = tok0 - (int)d.row0, head = kvh * 4 + (wave >> 1);
    d.dstr = 1; d.res = 0; d.Lf = L; d.ocol = head * 64; d.qb = ((size_t)head * T_ALL + d.row0) * 64; d.kb = ((size_t)(8 + kvh) * T_ALL + d.row0) * 64; d.vb = ((size_t)(10 + kvh) * T_ALL + d.row0) * 64; d.jq0 = q0 + 32 * (wave & 1); d.jk0 = q0 - 128; d.t_lo = 0; d.lbcol = 0;
    d.sink2 = sink_a[head] * 1.4426950408889634f; return d;
}
__device__ __forceinline__ AUnit unit_b(int u, int wave) {
    constexpr int NSL = T_ALL / 256; AUnit d; const int hb = u / NSL, sl = u % NSL; const int g = hb >> 2; const int dl = (g == 0) ? 1 : (g == 1 ? 4 : 16);
    int L, e;
    if (sl < T_P / 256) { d.row0 = (size_t)(sl / (L_P / 256)) * L_P; e = sl % (L_P / 256); L = L_P; } else { const int s2 = sl - T_P / 256; d.row0 = (size_t)T_P + (size_t)(s2 / (L_S / 256)) * L_S; e = s2 % (L_S / 256); L = L_S; }
    const int fb = e / dl, j0 = fb * 256;
    d.dstr = dl; d.res = e % dl; d.Lf = L / dl; d.ocol = hb * 64; { const size_t f0 = d.row0 + (size_t)d.res * d.Lf; d.qb = ((size_t)(12 + hb) * T_ALL + f0) * 64; d.kb = ((size_t)(24 + hb) * T_ALL + f0) * 64; d.vb = ((size_t)(36 + hb) * T_ALL + f0) * 64; } d.jq0 = j0 + 32 * wave; d.jk0 = j0 - 64; d.t_lo = wave >> 1; d.lbcol = hb; d.slot0 = 0; d.sink2 = 0.f; return d;
}

__device__ __forceinline__ void attention_phase(const Args& a, LAS unsigned char* lds, int vcu, int G, const int wave) {
    int lane = lane_id(); asm volatile("" : "+v"(lane));
    const int tid = wave * 64 + lane;
    bf16_t* QKV = (bf16_t*)(a.ws + WS_QKV); float* LB = (float*)(a.ws + WS_LB);
    bf16_t* AO = (bf16_t*)a.out; bf16_t* OBG = AO + (size_t)T_ALL * KBR;
    constexpr int NUA = (T_ALL / 64) * 2;
    { const int per = (NUA + G - 1) / G; const int ub = vcu * per; int nall = NUA - ub; nall = nall < 0 ? 0 : (nall > per ? per : nall);
      const int runlen = ((T_ALL / 64) % per == 0) ? per : 1;
      for (int rs = 0; rs < nall; rs += runlen) { const int u0 = ub + rs; const int n = (nall - rs) < runlen ? (nall - rs) : runlen;
      const int row = tid >> 3, c = tid & 7;
      LAS unsigned char* kd = lds + AT_K + c * 1024 + ((row & ~7) | ((row ^ c) & 7)) * 16;
      LAS unsigned char* vd = lds + AT_V + ((c >> 2) * 4 + (row >> 4)) * 1024 + (row & 15) * 64 + (c & 3) * 16;
      if (n > 0) {
          const int kvh = u0 / (T_ALL / 64), g0 = u0 % (T_ALL / 64);
          const bf16_t* Kh = QKV + (size_t)(8 + kvh) * T_ALL * 64 + (size_t)row * 64 + c * 8; const bf16_t* Vh = QKV + (size_t)(10 + kvh) * T_ALL * 64 + (size_t)row * 64 + c * 8;
          u32x4 kn, vn; bf16x8 qn[4];
          { u32x4 k5[5], v5[5];
#pragma unroll
            for (int t = 0; t < 5; ++t) { int g = g0 - 2 + t; g = g < 0 ? 0 : (g > T_ALL / 64 - 1 ? T_ALL / 64 - 1 : g); k5[t] = *(const u32x4*)(Kh + (size_t)g * 4096); v5[t] = *(const u32x4*)(Vh + (size_t)g * 4096); }
            { const AUnit d = unit_a(u0, wave, a.sink_a, 0.f); const bf16_t* qp = QKV + d.qb + (size_t)(d.jq0 + (lane & 31)) * 64 + (lane >> 5) * 8;
#pragma unroll
              for (int d0 = 0; d0 < 4; ++d0) qn[d0] = *(const bf16x8*)(qp + d0 * 16); }
#pragma unroll
            for (int t = 0; t < 5; ++t) { const int sl = (g0 + 4 + t) % 6; *(LAS u32x4*)(kd + sl * 8192) = k5[t]; *(LAS u32x4*)(vd + sl * 8192) = v5[t]; } }
          for (int i = 0; i < n; ++i) { const AUnit d = unit_a(u0 + i, wave, a.sink_a, 0.f);
              if (i > 0) { const int sl = (g0 + i + 2) % 6; *(LAS u32x4*)(kd + sl * 8192) = kn; *(LAS u32x4*)(vd + sl * 8192) = vn; }
              bf16x8 qr[4] = {qn[0], qn[1], qn[2], qn[3]};
              __syncthreads();
              if (i + 1 < n) { int g = g0 + i + 3; g = g > T_ALL / 64 - 1 ? T_ALL / 64 - 1 : g; kn = *(const u32x4*)(Kh + (size_t)g * 4096); vn = *(const u32x4*)(Vh + (size_t)g * 4096);
                  const AUnit dn = unit_a(u0 + i + 1, wave, a.sink_a, 0.f); const bf16_t* qp = QKV + dn.qb + (size_t)(dn.jq0 + (lane & 31)) * 64 + (lane >> 5) * 8;
#pragma unroll
                  for (int d0 = 0; d0 < 4; ++d0) qn[d0] = *(const bf16x8*)(qp + d0 * 16); }
              at_compute<5, true>(lds, AO, LB, d, qr, 128, lane, wave);
              __syncthreads(); } } } }
    constexpr int NUB = 12 * (T_ALL / 256);
    { const int per = (NUB + G - 1) / G; const int u0 = vcu * per; int n = NUB - u0; n = n < 0 ? 0 : (n > per ? per : n);
      u32x4 kreg[6], vreg[6]; bf16x8 qn[4];
      if (n > 0) { const AUnit d = unit_b(u0, wave); at_issue<6>(QKV, d, tid, kreg, vreg, qn); }
      for (int i = 0; i < n; ++i) { const AUnit d = unit_b(u0 + i, wave);
          at_stage<6>(lds, tid, kreg, vreg); bf16x8 qr[4] = {qn[0], qn[1], qn[2], qn[3]};
          __syncthreads();
          if (i + 1 < n) { const AUnit dn = unit_b(u0 + i + 1, wave); at_issue<6>(QKV, dn, tid, kreg, vreg, qn); }
          at_compute<3, false>(lds, OBG, LB, d, qr, 64, lane, wave);
          __syncthreads(); } }
}

__device__ __forceinline__ void combine_phase(const Args& a, int vcu, int G, const int wave) {
    int tid = lane_id(); asm volatile("" : "+v"(tid)); tid += wave * 64;
    bf16_t* AO = (bf16_t*)a.out; const bf16_t* OBG = AO + (size_t)T_ALL * KBR; const float* LB = (const float*)(a.ws + WS_LB);
    const int NT = G * 512;
    for (int i0 = vcu * 512 + tid; i0 < T_ALL * 32; i0 += 4 * NT) {
        u32x4 v[4][3]; float lg[4][3];
#pragma unroll
        for (int k = 0; k < 4; ++k) { const int i = i0 + k * NT; const bool ok = i < T_ALL * 32; const size_t tok = (size_t)((ok ? i : i0) >> 5); const int hp = (i >> 3) & 3, ch = i & 7;
#pragma unroll
            for (int g = 0; g < 3; ++g) { lg[k][g] = LB[tok * 12 + 4 * g + hp]; v[k][g] = *(const u32x4*)(OBG + tok * KBR + (4 * g + hp) * 64 + ch * 8); } }
#pragma unroll
        for (int k = 0; k < 4; ++k) { const int i = i0 + k * NT; if (i >= T_ALL * 32) break; const size_t tok = (size_t)(i >> 5); const int hp = (i >> 3) & 3, ch = i & 7;
            const float rl = __builtin_amdgcn_rcpf(lg[k][0] + lg[k][1] + lg[k][2]) * AO8_SCALE; float o[8];
            o[0] = bf_lo(v[k][0].x) + bf_lo(v[k][1].x) + bf_lo(v[k][2].x); o[1] = bf_hi(v[k][0].x) + bf_hi(v[k][1].x) + bf_hi(v[k][2].x);
            o[2] = bf_lo(v[k][0].y) + bf_lo(v[k][1].y) + bf_lo(v[k][2].y); o[3] = bf_hi(v[k][0].y) + bf_hi(v[k][1].y) + bf_hi(v[k][2].y);
            o[4] = bf_lo(v[k][0].z) + bf_lo(v[k][1].z) + bf_lo(v[k][2].z); o[5] = bf_hi(v[k][0].z) + bf_hi(v[k][1].z) + bf_hi(v[k][2].z);
            o[6] = bf_lo(v[k][0].w) + bf_lo(v[k][1].w) + bf_lo(v[k][2].w); o[7] = bf_hi(v[k][0].w) + bf_hi(v[k][1].w) + bf_hi(v[k][2].w);
            u32x2 w; w.x = cvt_pk_fp8x4(o[0] * rl, o[1] * rl, o[2] * rl, o[3] * rl); w.y = cvt_pk_fp8x4(o[4] * rl, o[5] * rl, o[6] * rl, o[7] * rl);
            *(u32x2*)((unsigned char*)AO + tok * KBR + 512 + hp * 64 + ch * 8) = w; } }
}

constexpr int NPH = 8;
__global__ void __launch_bounds__(512, 2) fwd_megakernel(Args args) {
    extern __shared__ __attribute__((aligned(16))) unsigned char lds_raw[];
    LAS unsigned char* lds = (LAS unsigned char*)lds_raw;
    int wave_ = __builtin_amdgcn_readfirstlane(threadIdx.x >> 6); asm volatile("" : "+s"(wave_)); const int wave = wave_;
    const int G = gridDim.x, bx = blockIdx.x; const int vcu = (G % 8 == 0) ? (bx % 8) * (G / 8) + bx / 8 : bx;
    unsigned char* ws = args.ws;
    const int lo = args.ph_lo, hi = args.ph_hi;
#define IN(k) (lo <= (k) && (k) < hi)
    volatile LAS unsigned* bst = (volatile LAS unsigned*)(lds + LDS_BYTES - 64);
    { const bool leader0 = (wave == 0) && (lane_id() == 0); if (leader0) { bst[0] = 0u; bst[1] = 0u; } }
    __syncthreads();
    XcdBarrier xbar; xbar.bar = (unsigned*)(ws + WS_BAR); xbar.x = xb_xcc_id(); xbar.st = bst;
    if (bx == 0) { for (int i = wave * 64 + lane_id(); i < XCD_BAR_WORDS; i += 512) __hip_atomic_store(xbar.bar + i, 0u, __ATOMIC_RELAXED, __HIP_MEMORY_SCOPE_AGENT); }
#define SEAM(k) do { if (IN(k) && IN((k) + 1)) { if ((k) == 0) { cg::this_grid().sync(); if ((wave == 0) && (lane_id() == 0)) (void)xb_add(&xbar.bar[XB_XCNT(xbar.x)], 1u); } else xcd_barrier(xbar, (wave == 0) && (lane_id() == 0)); } } while (0)
    bf16_t* QKV = (bf16_t*)(ws + WS_QKV); bf16_t* Gt = (bf16_t*)(ws + WS_G);
    float* ss1 = (float*)(ws + WS_SS1); float* ss2 = (float*)(ws + WS_SS2);
    if (IN(0)) { p0_prologue(args, lds, vcu, G, wave); }
    SEAM(0);
    if (IN(1)) {
        Gemm g{(const bf16_t*)args.out, (const bf16_t*)(ws + WS_WIN), T_ALL, NIN, DM / 2, DM / 2, DM / 2}; InProjOrder S; S.init(T_ALL, NIN, G, bx);
        { LAS float* lt = (LAS float*)(lds + 131072); int l2 = lane_id(); asm volatile("" : "+v"(l2)); const int t2 = wave * 64 + l2;
          if (t2 < 256) lt[t2] = ((const float*)(ws + WS_NORMT))[t2] * (((t2 >> 6) & 1) ? 1.0f : QSCALE);
          else if (t2 < 320) lt[t2] = ((const float*)(ws + WS_ROPE))[16 * 64 + (t2 - 256)];
          __syncthreads(); }
        EpiInProj E{QKV, Gt, ss1, (const f32x2*)(ws + WS_ROPE), (const LAS float*)(lds + 131072), 1.0f / (X8_SCALE * W8_SCALE)};
        gemm_phase<EpiInProj, InProjOrder, true, true, -1, true>(lds, g, S, E, wave);
    }
    SEAM(1);
    if (IN(2)) { attention_phase(args, lds, vcu, G, wave); }
    SEAM(2);
    if (IN(3)) { combine_phase(args, vcu, G, wave); }
    SEAM(3);
    if (IN(4)) {
        Gemm g{(const bf16_t*)args.out, (const bf16_t*)(ws + WS_WBR), T_ALL, DM, KBR / 2, KBR / 2, KBR / 2};   StaticOrder S; S.init(T_ALL, DM, G, bx); EpiBranchFused E{Gt, ws + WS_ACT};
        gemm_phase<EpiBranchFused, StaticOrder, true, true, 4, true>(lds, g, S, E, wave);
    }
    SEAM(4);
    if (IN(5)) {
        Gemm g{(const bf16_t*)(ws + WS_ACT), (const bf16_t*)(ws + WS_WOUT), T_ALL, DM, DM / 2, DM / 2, DM / 2}; StaticOrder S; S.init(T_ALL, DM, G, bx);
        EpiOutProj E{args.x_prompt, args.x_sample, args.out, (bf16_t*)(ws + WS_X1B), ss2, 1.0f / (MIX8_SCALE * W8_SCALE)};
        gemm_phase<EpiOutProj, StaticOrder, true, true, -1, true>(lds, g, S, E, wave);
    }
    SEAM(5);
    if (IN(6)) {
        Gemm g{(const bf16_t*)(ws + WS_X1B), (const bf16_t*)(ws + WS_WGU), T_ALL, NGU, DM, DM, DM}; StaticOrder S; S.init(T_ALL, NGU, G, bx);
        EpiGateUp E{(bf16_t*)(ws + WS_ACT), ss2};
        gemm_phase<EpiGateUp, StaticOrder, true, true>(lds, g, S, E, wave);
    }
    SEAM(6);
    if (IN(7)) {
        Gemm g{(const bf16_t*)(ws + WS_ACT), (const bf16_t*)(ws + WS_WD), T_ALL, DM, DFF, DFF, DFF}; StaticOrder S; S.init(T_ALL, DM, G, bx);
        EpiDown E{args.out, (const bf16_t*)(ws + WS_X1B)};
        gemm_phase<EpiDown, StaticOrder, true, true>(lds, g, S, E, wave);
    }
#undef IN
#undef SEAM
}

#ifndef MK_N_LAUNCHES
#define MK_N_LAUNCHES 1
#endif

extern "C" void kernel_launch(void* const* d_in, const int* in_sizes, int n_in, void* d_out, int out_size, void* d_ws, size_t ws_size, hipStream_t stream) {
    static int grid = 0;
    if (grid == 0) {
        if (n_in != 16 || out_size != T_ALL * DM || ws_size < WS_END) { fprintf(stderr, "kernel_launch: unexpected shapes: n_in %d out %d ws %zu (need %zu)\n", n_in, out_size, ws_size, (size_t)WS_END); grid = -1; return; }
        int dev = 0, cus = 0, per_cu = 0;
        hipGetDevice(&dev); hipDeviceGetAttribute(&cus, hipDeviceAttributeMultiprocessorCount, dev);
        if (hipFuncSetAttribute((const void*)fwd_megakernel, hipFuncAttributeMaxDynamicSharedMemorySize, LDS_BYTES) != hipSuccess) { fprintf(stderr, "kernel_launch: hipFuncSetAttribute failed\n"); grid = -1; return; }
        if (hipOccupancyMaxActiveBlocksPerMultiprocessor(&per_cu, (const void*)fwd_megakernel, 512, LDS_BYTES) != hipSuccess || per_cu < 1) { fprintf(stderr, "kernel_launch: occupancy query says %d\n", per_cu); per_cu = 1; }
        (void)hipGetLastError();
        grid = cus * 1;
        fprintf(stderr, "kernel_launch: cus %d per_cu %d grid %d\n", cus, per_cu, grid);
    }
    if (grid < 0) return;
    Args a{};
    a.x_prompt = (const float*)d_in[0]; a.x_sample = (const float*)d_in[1]; a.norm1 = (const float*)d_in[2]; a.w_in = (const float*)d_in[3]; a.qn_a = (const float*)d_in[4]; a.kn_a = (const float*)d_in[5];
    a.sink_a = (const float*)d_in[6]; a.qn_b = (const float*)d_in[7]; a.kn_b = (const float*)d_in[8]; a.w_br_a = (const float*)d_in[9]; a.w_br_b = (const float*)d_in[10]; a.w_out = (const float*)d_in[11];
    a.norm2 = (const float*)d_in[12]; a.w_gate = (const float*)d_in[13]; a.w_up = (const float*)d_in[14]; a.w_down = (const float*)d_in[15];
    a.out = (float*)d_out; a.ws = (unsigned char*)d_ws;
    for (int c = 0; c < 32; ++c) a.inv_freq[c] = (float)pow(10000.0, -(double)c / 32.0);
#if MK_N_LAUNCHES == 1
    a.ph_lo = 0; a.ph_hi = NPH;
    void* kargs[] = {&a};
    hipError_t e = hipLaunchCooperativeKernel((const void*)fwd_megakernel, dim3(grid), dim3(512), kargs, LDS_BYTES, stream);
    if (e != hipSuccess) fprintf(stderr, "kernel_launch: cooperative launch failed: %s (grid %d)\n", hipGetErrorString(e), grid);
#else
    for (int p = 0; p < NPH; ++p) { a.ph_lo = p; a.ph_hi = p + 1; hipLaunchKernelGGL(fwd_megakernel, dim3(grid), dim3(512), LDS_BYTES, stream, a); }
#endif
}
```

```cpp
#include <hip/hip_runtime.h>
#include <hip/hip_cooperative_groups.h>
#include <cstdio>
#include <cstdint>
#include <cmath>
namespace cg = cooperative_groups;

namespace pg8 {
#define PG8_LAS __attribute__((address_space(3)))
typedef unsigned short bf16_t;
typedef short bf16x8 __attribute__((ext_vector_type(8)));
typedef float f32x4 __attribute__((ext_vector_type(4)));
typedef unsigned u32x4 __attribute__((ext_vector_type(4)));
typedef unsigned u32x2 __attribute__((ext_vector_type(2)));
__device__ __forceinline__ int lane_id() { return (int)__builtin_amdgcn_mbcnt_hi(~0u, __builtin_amdgcn_mbcnt_lo(~0u, 0u)); }
typedef int v4i_t __attribute__((ext_vector_type(4)));
typedef int v8i_t __attribute__((ext_vector_type(8)));
__device__ __forceinline__ v8i_t cat8(bf16x8 lo, bf16x8 hi) { const v4i_t a = __builtin_bit_cast(v4i_t, lo), b = __builtin_bit_cast(v4i_t, hi); return __builtin_shufflevector(a, b, 0, 1, 2, 3, 4, 5, 6, 7); }
constexpr int BM = 256, BK = 64, HALF = 128, HTB = HALF * BK * 2  , STAGE_BYTES = 8 * HTB, NXCD = 8, WGM = 4;

__host__ __device__ __forceinline__ int lds_byte(int r, int c) { const int st = (r >> 4) * 2 + (c >> 5), rr = r & 15, cc = c & 31, ob = rr * 64 + cc * 2; return st * 1024 + (ob ^ (((ob >> 9) & 1) << 5)); }
__host__ __device__ __forceinline__ void stage_rc(int b, int& R, int& C) { const int st = b / 1024, sb = b % 1024, swz = sb ^ (((sb >> 9) & 1) << 5); R = (st >> 1) * 16 + swz / 64; C = (st & 1) * 32 + (swz % 64) / 2; }
__host__ __device__ __forceinline__ int perm32(int rho) { const int n = rho >> 4, i = rho & 15; return 8 * (i >> 2) + 4 * n + (i & 3); }

struct Unit { int pm, pn; };
struct Gemm { const bf16_t* A; const bf16_t* Bt; int M, N, K, lda, ldb; };

struct StaticOrder {
    int nM, nN, nwg, G, c;
    __host__ __device__ void init(int M, int N, int G_, int c_) { nM = M / BM; nN = N / BM; nwg = nM * nN; G = G_; c = c_; }
    __host__ __device__ bool next(int i, Unit& u) const {
        const long L = (long)i * G + c; if (L >= nwg) return false;
        int wgid = (int)L; { const int q = nwg / NXCD, r = nwg % NXCD, xcd = wgid % NXCD, off = wgid / NXCD; wgid = (xcd < r ? xcd * (q + 1) : r * (q + 1) + (xcd - r) * q) + off; }
        const int nig = WGM * nN, gid = wgid / nig, fm = gid * WGM, gsz = (nM - fm) < WGM ? (nM - fm) : WGM;
        u.pm = fm + ((wgid % nig) % gsz); u.pn = (wgid % nig) / gsz; return true;
    }
    __device__ __forceinline__ void a_ready(const Unit&) const {}
    __device__ __forceinline__ void done(const Unit&) const {}
};

struct InProjOrder : StaticOrder {
    __device__ bool next(int i, Unit& u) const { const bool ok = StaticOrder::next(i, u); if (ok) u.pn = (u.pn == 8) ? 9 : (u.pn == 9) ? 10 : (u.pn == 10) ? 8 : u.pn; return ok; }
};
typedef float f32x2 __attribute__((ext_vector_type(2)));
typedef __bf16 bf16x2_t __attribute__((ext_vector_type(2)));
__device__ __forceinline__ unsigned cvt_pk_bf16(float lo, float hi) { f32x2 v = {lo, hi}; bf16x2_t b = __builtin_convertvector(v, bf16x2_t); return __builtin_bit_cast(unsigned, b); }
__device__ __forceinline__ unsigned cvt_pk_fp8x4(float a, float b, float c, float d) { int w = 0; w = __builtin_amdgcn_cvt_pk_fp8_f32(a, b, w, false); w = __builtin_amdgcn_cvt_pk_fp8_f32(c, d, w, true); return (unsigned)w; }
constexpr float X8_SCALE = 16.0f, W8_SCALE = 512.0f, MIX8_SCALE = 64.0f, AO8_SCALE = 32.0f, WBR8_SCALE = 256.0f;
__device__ __forceinline__ float bf_lo(unsigned w) { return __uint_as_float(w << 16); }
__device__ __forceinline__ float bf_hi(unsigned w) { return __uint_as_float(w & 0xffff0000u); }
__device__ __forceinline__ float fast_sigmoid(float v) { return __builtin_amdgcn_rcpf(1.0f + __builtin_amdgcn_exp2f(-1.4426950408889634f * v)); }

constexpr int DM = 1024, T_P = 65536, T_S = 32768, T_ALL = T_P + T_S, L_P = 4096, L_S = 16384;
constexpr int NIN = 5120, NQKV = 3072, NGATE = 2048, DFF = 2816, NGU = 2 * DFF, KBR = 768;
constexpr float EPS = 1e-6f;
constexpr float QSCALE = 0.125f * 1.4426950408889634f;


__device__ __forceinline__ size_t qh_tau(int hs, int row) {
    if (hs < 12) return (size_t)row;
    const int sh = 2 * (((hs - 12) % 12) >> 2);
    const int Lm = (row < T_P) ? (L_P - 1) : (L_S - 1), lsh = (row < T_P) ? 12 : 14, pos = row & Lm;
    return (size_t)((row & ~Lm) + ((pos & ((1 << sh) - 1)) << (lsh - sh)) + (pos >> sh));
}
#define LANE_FRFQ int ln_ = lane_id(); asm volatile("" : "+v"(ln_)); const int fr = ln_ & 15, fq = ln_ >> 4
#define SHFLX(x, m) __int_as_float(__builtin_amdgcn_ds_bpermute((ln_ ^ (m)) << 2, __float_as_int(x)))
#define ROT4(c, s, rc, rs_) do { const f32x4 _c = c * rc - s * rs_; s = s * rc + c * rs_; c = _c; } while (0)
struct EpiInProj {
    static constexpr bool PERM = true, AFTER_DRAIN = false;
    bf16_t* QKV; bf16_t* G; const float* ss1; const f32x2* rope; const PG8_LAS float* ltab; float oscale;
    __device__ __forceinline__ void operator()(const f32x4 (&acc)[2][2][4][2], const Unit& u, int wr, int wc, int, int) const {
        LANE_FRFQ; const int pn = u.pn; int row0 = u.pm * BM + wr * 64 + fr; asm volatile("" : "+v"(row0));
        float rsv[8];
#pragma unroll
        for (int i = 0; i < 8; ++i) rsv[i] = ss1[row0 + (i >> 2) * HALF + (i & 3) * 16];
        int kind, nidx;
        if (pn < 2) { kind = 1; nidx = 0; } else if (pn == 2) { kind = (wc < 2) ? 2 : 0; nidx = 1; } else if (pn < 6) { kind = 1; nidx = 2; } else if (pn < 9) { kind = 2; nidx = 3; } else if (pn < 12) { kind = 0; nidx = 3; } else { kind = 3; nidx = 3; }
        if (kind == 3) {
#pragma unroll
            for (int i = 0; i < 8; ++i) { const int ai = i >> 2, m = i & 3; const float rs = __builtin_amdgcn_rsqf(rsv[i] * (1.0f / DM) + EPS) * oscale * -1.4426950408889634f;
                bf16_t* rowp = G + (size_t)(row0 + ai * HALF + m * 16) * NGATE + (pn - 12) * 128 + wc * 32 + fq * 8;
                float r[8], gb[8];
#pragma unroll
                for (int n = 0; n < 2; ++n)
#pragma unroll
                    for (int j = 0; j < 4; ++j) { const float ea = __builtin_amdgcn_exp2f(acc[ai][0][m][n][j] * rs), eb = __builtin_amdgcn_exp2f(acc[ai][1][m][n][j] * rs);
                        gb[4 * n + j] = __builtin_amdgcn_rcpf(1.0f + eb); r[4 * n + j] = (1.0f + eb) * __builtin_amdgcn_rcpf(1.0f + ea); }
                u32x4 w; w.x = cvt_pk_bf16(r[0], r[1]); w.y = cvt_pk_bf16(r[2], r[3]); w.z = cvt_pk_bf16(r[4], r[5]); w.w = cvt_pk_bf16(r[6], r[7]);
                __builtin_nontemporal_store(w, (u32x4*)rowp);
                w.x = cvt_pk_bf16(gb[0], gb[1]); w.y = cvt_pk_bf16(gb[2], gb[3]); w.z = cvt_pk_bf16(gb[4], gb[5]); w.w = cvt_pk_bf16(gb[6], gb[7]);
                __builtin_nontemporal_store(w, (u32x4*)(rowp + DM)); }
            return;
        }
        if (kind == 0) {
            const int hs = 4 * pn + wc, sh = (hs < 12) ? 0 : 2 * (((hs - 12) % 12) >> 2);
            bf16_t* qbase = QKV + ((size_t)hs * T_ALL + qh_tau(hs, row0)) * 64 + fq * 8;
#pragma unroll
            for (int i = 0; i < 8; ++i) { const int ai = i >> 2, m = i & 3; const float rs = __builtin_amdgcn_rsqf(rsv[i] * (1.0f / DM) + EPS) * oscale;
                bf16_t* rowp = qbase + (size_t)((ai * HALF + m * 16) >> sh) * 64;
#pragma unroll
                for (int bj = 0; bj < 2; ++bj) { f32x4 v0 = acc[ai][bj][m][0] * rs, v1 = acc[ai][bj][m][1] * rs; u32x4 w;
                    w.x = cvt_pk_bf16(v0[0], v0[1]); w.y = cvt_pk_bf16(v0[2], v0[3]); w.z = cvt_pk_bf16(v1[0], v1[1]); w.w = cvt_pk_bf16(v1[2], v1[3]);
                    __builtin_nontemporal_store(w, (u32x4*)(rowp + bj * 32)); } }
            return;
        }
        const PG8_LAS float* nw = ltab + nidx * 64 + fq * 8; const PG8_LAS float* r16 = ltab + 256 + fq * 16;
        const int pos0 = (row0 < T_P) ? (row0 & (L_P - 1)) : (row0 & (L_S - 1));
        f32x4 tb[4];
#pragma unroll
        for (int i = 0; i < 4; ++i) tb[i] = *(const f32x4*)(rope + (size_t)pos0 * 32 + fq * 8 + 2 * i);
        f32x4 cc[2], sc[2];
#pragma unroll
        for (int n = 0; n < 2; ++n) { cc[n] = (f32x4){tb[2 * n][0], tb[2 * n][2], tb[2 * n + 1][0], tb[2 * n + 1][2]}; sc[n] = (f32x4){tb[2 * n][1], tb[2 * n][3], tb[2 * n + 1][1], tb[2 * n + 1][3]}; }
        const int hs = 4 * pn + wc, sh = (hs < 12) ? 0 : 2 * (((hs - 12) % 12) >> 2);
        bf16_t* qbase = QKV + ((size_t)hs * T_ALL + qh_tau(hs, row0)) * 64 + fq * 8;
#pragma unroll
        for (int ai = 0; ai < 2; ++ai) {
#pragma unroll
            for (int m = 0; m < 4; ++m) {
                f32x4 gw[2][2];
#pragma unroll
                for (int bj = 0; bj < 2; ++bj)
#pragma unroll
                    for (int n = 0; n < 2; ++n) gw[bj][n] = *(const PG8_LAS f32x4*)(nw + bj * 32 + n * 4);
                if (ai + m > 0) {
                    f32x4 t16[4], c16[2], s16[2];
#pragma unroll
                    for (int i = 0; i < 4; ++i) t16[i] = *(const PG8_LAS f32x4*)(r16 + 4 * i);
#pragma unroll
                    for (int n = 0; n < 2; ++n) { c16[n] = (f32x4){t16[2 * n][0], t16[2 * n][2], t16[2 * n + 1][0], t16[2 * n + 1][2]}; s16[n] = (f32x4){t16[2 * n][1], t16[2 * n][3], t16[2 * n + 1][1], t16[2 * n + 1][3]}; }
#pragma unroll
                    for (int rep = 0; rep < ((ai == 1 && m == 0) ? 5 : 1); ++rep)
#pragma unroll
                        for (int n = 0; n < 2; ++n) ROT4(cc[n], sc[n], c16[n], s16[n]); }
                const float rs = __builtin_amdgcn_rsqf(rsv[ai * 4 + m] * (1.0f / DM) + EPS) * oscale;
                f32x4 v[2][2]; float ssq = 0.f;
#pragma unroll
                for (int bj = 0; bj < 2; ++bj)
#pragma unroll
                    for (int n = 0; n < 2; ++n) { v[bj][n] = acc[ai][bj][m][n] * rs; ssq += (v[bj][n][0] * v[bj][n][0] + v[bj][n][1] * v[bj][n][1]) + (v[bj][n][2] * v[bj][n][2] + v[bj][n][3] * v[bj][n][3]); }
                ssq += SHFLX(ssq, 16); ssq += SHFLX(ssq, 32);
                const float r2 = __builtin_amdgcn_rsqf(ssq * (1.0f / 64.0f) + EPS);
#pragma unroll
                for (int bj = 0; bj < 2; ++bj)
#pragma unroll
                    for (int n = 0; n < 2; ++n) v[bj][n] = v[bj][n] * r2 * gw[bj][n];
                f32x4 olo[2], ohi[2];
#pragma unroll
                for (int n = 0; n < 2; ++n) { olo[n] = v[0][n] * cc[n] - v[1][n] * sc[n]; ohi[n] = v[1][n] * cc[n] + v[0][n] * sc[n]; }
                bf16_t* rowp = qbase + (size_t)((ai * HALF + m * 16) >> sh) * 64; u32x4 w;
                w.x = cvt_pk_bf16(olo[0][0], olo[0][1]); w.y = cvt_pk_bf16(olo[0][2], olo[0][3]); w.z = cvt_pk_bf16(olo[1][0], olo[1][1]); w.w = cvt_pk_bf16(olo[1][2], olo[1][3]);
                __builtin_nontemporal_store(w, (u32x4*)(rowp));
                w.x = cvt_pk_bf16(ohi[0][0], ohi[0][1]); w.y = cvt_pk_bf16(ohi[0][2], ohi[0][3]); w.z = cvt_pk_bf16(ohi[1][0], ohi[1][1]); w.w = cvt_pk_bf16(ohi[1][2], ohi[1][3]);
                __builtin_nontemporal_store(w, (u32x4*)(rowp + 32));
                asm volatile("" ::: "memory"); } }
    }
};

template <int SECOND> struct EpiBranch {
    static constexpr bool PERM = true, AFTER_DRAIN = false;
    bf16_t* G;
    __device__ __forceinline__ void operator()(const f32x4 (&acc)[2][2][4][2], const Unit& u, int wr, int wc, int, int) const {
        LANE_FRFQ;
        int row0 = u.pm * BM + wr * 64 + fr; asm volatile("" : "+v"(row0)); const int col0 = u.pn * BM + wc * 32 + 8 * fq;
        bf16_t* base = G + (size_t)row0 * NGATE + col0;
#pragma unroll
        for (int ai = 0; ai < 2; ++ai) {
            u32x4 gt[4][2], pv[4][2];
#pragma unroll
            for (int m = 0; m < 4; ++m)
#pragma unroll
                for (int bj = 0; bj < 2; ++bj) { const bf16_t* p = base + (size_t)(ai * HALF + m * 16) * NGATE + bj * HALF; gt[m][bj] = *(const u32x4*)(p + (SECOND ? DM : 0)); if (SECOND) pv[m][bj] = *(const u32x4*)p; }
#pragma unroll
            for (int m = 0; m < 4; ++m)
#pragma unroll
                for (int bj = 0; bj < 2; ++bj) { const f32x4 a0 = acc[ai][bj][m][0], a1 = acc[ai][bj][m][1]; const u32x4 g = gt[m][bj];
                    float o[8] = {a0[0] * bf_lo(g.x), a0[1] * bf_hi(g.x), a0[2] * bf_lo(g.y), a0[3] * bf_hi(g.y), a1[0] * bf_lo(g.z), a1[1] * bf_hi(g.z), a1[2] * bf_lo(g.w), a1[3] * bf_hi(g.w)};
                    if (SECOND) { const u32x4 q = pv[m][bj];
                        o[0] += bf_lo(q.x); o[1] += bf_hi(q.x); o[2] += bf_lo(q.y); o[3] += bf_hi(q.y); o[4] += bf_lo(q.z); o[5] += bf_hi(q.z); o[6] += bf_lo(q.w); o[7] += bf_hi(q.w); }
                    u32x4 w; w.x = cvt_pk_bf16(o[0], o[1]); w.y = cvt_pk_bf16(o[2], o[3]); w.z = cvt_pk_bf16(o[4], o[5]); w.w = cvt_pk_bf16(o[6], o[7]);
                    gt[m][bj] = w; }
#pragma unroll
            for (int m = 0; m < 4; ++m)
#pragma unroll
                for (int bj = 0; bj < 2; ++bj) *(u32x4*)(base + (size_t)(ai * HALF + m * 16) * NGATE + bj * HALF) = gt[m][bj];
        }
    }
};

struct EpiBranchFused {
    static constexpr bool PERM = true, AFTER_DRAIN = false;
    bf16_t* G; unsigned char* MIX8;
    __device__ __forceinline__ void mid(f32x4 (&acc)[2][2][4][2], const Unit& u, int wr, int wc, int, int) const {
        LANE_FRFQ;
        int row0 = u.pm * BM + wr * 64 + fr; asm volatile("" : "+v"(row0)); const int col0 = u.pn * BM + wc * 32 + 8 * fq;
        const bf16_t* base = G + (size_t)row0 * NGATE + col0;
#pragma unroll
        for (int ai = 0; ai < 2; ++ai) {
            u32x4 gr[4][2];
#pragma unroll
            for (int m = 0; m < 4; ++m)
#pragma unroll
                for (int bj = 0; bj < 2; ++bj) gr[m][bj] = *(const u32x4*)(base + (size_t)(ai * HALF + m * 16) * NGATE + bj * HALF);
#pragma unroll
            for (int m = 0; m < 4; ++m)
#pragma unroll
                for (int bj = 0; bj < 2; ++bj) { const u32x4 a = gr[m][bj];
                    acc[ai][bj][m][0] = acc[ai][bj][m][0] * (f32x4){bf_lo(a.x), bf_hi(a.x), bf_lo(a.y), bf_hi(a.y)};
                    acc[ai][bj][m][1] = acc[ai][bj][m][1] * (f32x4){bf_lo(a.z), bf_hi(a.z), bf_lo(a.w), bf_hi(a.w)}; }
        }
    }
    __device__ __forceinline__ void operator()(const f32x4 (&acc)[2][2][4][2], const Unit& u, int wr, int wc, int, int) const {
        LANE_FRFQ;
        int row0 = u.pm * BM + wr * 64 + fr; asm volatile("" : "+v"(row0)); const int col0 = u.pn * BM + wc * 32 + 8 * fq;
        const bf16_t* base = G + (size_t)row0 * NGATE + col0;
        u32x4 gb[2][4][2];
#pragma unroll
        for (int ai = 0; ai < 2; ++ai)
#pragma unroll
            for (int m = 0; m < 4; ++m)
#pragma unroll
                for (int bj = 0; bj < 2; ++bj) gb[ai][m][bj] = *(const u32x4*)(base + (size_t)(ai * HALF + m * 16) * NGATE + bj * HALF + DM);
#pragma unroll
        for (int ai = 0; ai < 2; ++ai)
#pragma unroll
            for (int m = 0; m < 4; ++m)
#pragma unroll
                for (int bj = 0; bj < 2; ++bj) { const f32x4 a0 = acc[ai][bj][m][0] * (MIX8_SCALE / (AO8_SCALE * WBR8_SCALE)), a1 = acc[ai][bj][m][1] * (MIX8_SCALE / (AO8_SCALE * WBR8_SCALE));   const u32x4 g = gb[ai][m][bj]; u32x2 w;
                    w.x = cvt_pk_fp8x4(a0[0] * bf_lo(g.x), a0[1] * bf_hi(g.x), a0[2] * bf_lo(g.y), a0[3] * bf_hi(g.y)); w.y = cvt_pk_fp8x4(a1[0] * bf_lo(g.z), a1[1] * bf_hi(g.z), a1[2] * bf_lo(g.w), a1[3] * bf_hi(g.w));
                    *(u32x2*)(MIX8 + (size_t)(row0 + ai * HALF + m * 16) * DM + col0 + bj * HALF) = w; }
    }
};

struct EpiOutProj {
    static constexpr bool PERM = false, AFTER_DRAIN = false;
    const float* xp; const float* xs; float* out; bf16_t* X1B; float* ss2; float oscale;
    __device__ __forceinline__ void operator()(const f32x4 (&acc)[2][2][4][2], const Unit& u, int wr, int wc, int, int) const {
        LANE_FRFQ;
        const int rowt = u.pm * BM; const float* xb = (rowt < T_P) ? xp + (size_t)rowt * DM : xs + (size_t)(rowt - T_P) * DM;
        int rl0 = wr * 64 + fr; asm volatile("" : "+v"(rl0)); const int col0 = u.pn * BM + wc * 32 + 4 * fq;
#pragma unroll
        for (int ai = 0; ai < 2; ++ai) {
            f32x4 xv[4][2][2];
#pragma unroll
            for (int m = 0; m < 4; ++m)
#pragma unroll
                for (int bj = 0; bj < 2; ++bj)
#pragma unroll
                    for (int n = 0; n < 2; ++n) xv[m][bj][n] = __builtin_nontemporal_load((const f32x4*)(xb + (size_t)(rl0 + ai * HALF + m * 16) * DM + col0 + bj * HALF + n * 16));
#pragma unroll
            for (int m = 0; m < 4; ++m) { const int rl = rl0 + ai * HALF + m * 16; const size_t goff = (size_t)(rowt + rl) * DM + col0; float s = 0.f;
#pragma unroll
                for (int bj = 0; bj < 2; ++bj)
#pragma unroll
                    for (int n = 0; n < 2; ++n) { const f32x4 o = xv[m][bj][n] + acc[ai][bj][m][n] * oscale;
                        u32x2 w; w.x = cvt_pk_bf16(o[0], o[1]); w.y = cvt_pk_bf16(o[2], o[3]);
                        *(u32x2*)(X1B + goff + bj * HALF + n * 16) = w; s += (o[0] * o[0] + o[1] * o[1]) + (o[2] * o[2] + o[3] * o[3]); }
                s += SHFLX(s, 16); s += SHFLX(s, 32);
                if (fq == 0) atomicAdd(ss2 + rowt + rl, s); }
        }
    }
};

struct EpiGateUp {
    static constexpr bool PERM = true, AFTER_DRAIN = false;
    bf16_t* ACT; const float* ss2;
    __device__ __forceinline__ void operator()(const f32x4 (&acc)[2][2][4][2], const Unit& u, int wr, int wc, int, int) const {
        LANE_FRFQ;
        int row0 = u.pm * BM + wr * 64 + fr; asm volatile("" : "+v"(row0)); const int col0 = u.pn * HALF + wc * 32 + 8 * fq;
        float rsv[8];
#pragma unroll
        for (int i = 0; i < 8; ++i) rsv[i] = ss2[row0 + (i >> 2) * HALF + (i & 3) * 16];
#pragma unroll
        for (int ai = 0; ai < 2; ++ai)
#pragma unroll
            for (int m = 0; m < 4; ++m) { const int row = row0 + ai * HALF + m * 16; const float rs = __builtin_amdgcn_rsqf(rsv[ai * 4 + m] * (1.0f / DM) + EPS);
                float o[8];
#pragma unroll
                for (int n = 0; n < 2; ++n)
#pragma unroll
                    for (int j = 0; j < 4; ++j) { const float g = acc[ai][0][m][n][j] * rs, up = acc[ai][1][m][n][j] * rs; o[4 * n + j] = g * fast_sigmoid(g) * up; }
                u32x4 w; w.x = cvt_pk_bf16(o[0], o[1]); w.y = cvt_pk_bf16(o[2], o[3]); w.z = cvt_pk_bf16(o[4], o[5]); w.w = cvt_pk_bf16(o[6], o[7]);
                __builtin_nontemporal_store(w, (u32x4*)(ACT + (size_t)row * DFF + col0)); }
    }
};

struct EpiDown {
    static constexpr bool PERM = false, AFTER_DRAIN = false;
    float* out; const bf16_t* X1B;
    __device__ __forceinline__ void operator()(const f32x4 (&acc)[2][2][4][2], const Unit& u, int wr, int wc, int, int) const {
        LANE_FRFQ;
        int row0 = u.pm * BM + wr * 64 + fr; asm volatile("" : "+v"(row0)); const int col0 = u.pn * BM + wc * 32 + 4 * fq;
        u32x2 xv[2][4][2][2];
#pragma unroll
        for (int ai = 0; ai < 2; ++ai)
#pragma unroll
            for (int m = 0; m < 4; ++m)
#pragma unroll
                for (int bj = 0; bj < 2; ++bj)
#pragma unroll
                    for (int n = 0; n < 2; ++n) xv[ai][m][bj][n] = *(const u32x2*)(X1B + (size_t)(row0 + ai * HALF + m * 16) * DM + col0 + bj * HALF + n * 16);
#pragma unroll
        for (int ai = 0; ai < 2; ++ai)
#pragma unroll
            for (int m = 0; m < 4; ++m)
#pragma unroll
                for (int bj = 0; bj < 2; ++bj)
#pragma unroll
                    for (int n = 0; n < 2; ++n) { const u32x2 w = xv[ai][m][bj][n]; const f32x4 a = acc[ai][bj][m][n];
                        __builtin_nontemporal_store((f32x4){bf_lo(w.x) + a[0], bf_hi(w.x) + a[1], bf_lo(w.y) + a[2], bf_hi(w.y) + a[3]}, (f32x4*)(out + (size_t)(row0 + ai * HALF + m * 16) * DM + col0 + bj * HALF + n * 16)); }
    }
};

template <class Epi, class Sched, bool ALIGN_EPI = false, bool SP2 = false, int HOOK_T = -1, bool FP8 = false>
__device__ __forceinline__ void gemm_phase(PG8_LAS unsigned char* lds, const Gemm g, const Sched& S, const Epi& E, const int wid) {
    int lane = lane_id(); asm volatile("" : "+v"(lane));
    const int tid = wid * 64 + lane, wr = wid >> 2, wc = wid & 3, fr = lane & 15, fq = lane >> 4;
    const int K = g.K, nt = K / BK;
    unsigned voffA[2], voffB[2];
#pragma unroll
    for (int i = 0; i < 2; ++i) { int R, C; stage_rc(tid * 16 + i * 8192, R, C); const int Rb = Epi::PERM ? ((R & ~31) + perm32(R & 31)) : R;
        voffA[i] = (unsigned)(R * g.lda + C) * 2u; voffB[i] = (unsigned)(Rb * g.ldb + C) * 2u; }
    const size_t kstep = (size_t)(BK * 2);
    const size_t hstepA = (size_t)HALF * g.lda * 2, hstepB = (size_t)HALF * g.ldb * 2;
    const size_t tstepA = 2 * hstepA, tstepB = 2 * hstepB;
    const unsigned ldsw = (unsigned)wid * 1024u;
    const int aoff = lds_byte(wr * 64 + fr, fq * 8), boff = lds_byte(wc * 32 + fr, fq * 8);
#define PG8_SA(b, h) (((b) * 2 + (h)) * HTB)
#define PG8_SB(b, h) ((4 + (b) * 2 + (h)) * HTB)
#define PG8_STAGE(bufoff, gbase, voff) do { _Pragma("unroll") for (int _i = 0; _i < 2; ++_i) \
        __builtin_amdgcn_global_load_lds((const unsigned*)((const char*)(gbase) + (voff)[_i]), (PG8_LAS unsigned*)(lds + (bufoff) + ldsw + _i * 8192), 16, 0, 0); } while (0)
#define PG8_LDA(dst, b, h) do { _Pragma("unroll") for (int m = 0; m < 4; ++m) _Pragma("unroll") for (int k = 0; k < 2; ++k) dst[m][k] = *(const PG8_LAS bf16x8*)(lds + PG8_SA(b, h) + aoff + m * 2048 + k * 1024); } while (0)
#define PG8_LDB(dst, b, h) do { _Pragma("unroll") for (int n = 0; n < 2; ++n) _Pragma("unroll") for (int k = 0; k < 2; ++k) dst[n][k] = *(const PG8_LAS bf16x8*)(lds + PG8_SB(b, h) + boff + n * 2048 + k * 1024); } while (0)
#define PG8_MMA(ai, bj, At, Bt) do { __builtin_amdgcn_s_setprio(1); if constexpr (FP8) { _Pragma("unroll") for (int m = 0; m < 4; ++m) _Pragma("unroll") for (int n = 0; n < 2; ++n) \
        asm volatile("v_mfma_f32_16x16x128_f8f6f4 %0, %1, %2, %0" : "+v"(acc[ai][bj][m][n]) : "v"(cat8(Bt[n][0], Bt[n][1])), "v"(cat8(At[m][0], At[m][1]))); } else { \
        _Pragma("unroll") for (int m = 0; m < 4; ++m) _Pragma("unroll") for (int n = 0; n < 2; ++n) _Pragma("unroll") for (int k = 0; k < 2; ++k) \
        acc[ai][bj][m][n] = __builtin_amdgcn_mfma_f32_16x16x32_bf16(Bt[n][k], At[m][k], acc[ai][bj][m][n], 0, 0, 0); } __builtin_amdgcn_s_setprio(0); } while (0)
#define PG8_WAIT_V(n) asm volatile("s_waitcnt vmcnt(" #n ")" ::: "memory")
#define PG8_WAIT_L(n) asm volatile("s_waitcnt lgkmcnt(" #n ")" ::: "memory")
#define PG8_BAR __builtin_amdgcn_s_barrier()
#define PG8_SCHED __builtin_amdgcn_sched_barrier(0)
    Unit cur, nxt; int ui = 0;
    if (!S.next(0, cur)) return;
    f32x4 acc[2][2][4][2];
#pragma unroll
    for (int a = 0; a < 2; ++a)
#pragma unroll
        for (int b = 0; b < 2; ++b)
#pragma unroll
            for (int m = 0; m < 4; ++m)
#pragma unroll
                for (int n = 0; n < 2; ++n) acc[a][b][m][n] = (f32x4){0.f, 0.f, 0.f, 0.f};
    bf16x8 At[4][2], B0[2][2], B1[2][2];
    const char* cA = (const char*)g.A + (size_t)cur.pm * tstepA; const char* cB = (const char*)g.Bt + (size_t)cur.pn * tstepB;
    S.a_ready(cur);
    if constexpr (SP2) {
        PG8_STAGE(PG8_SB(0, 0), cB, voffB); PG8_STAGE(PG8_SB(0, 1), cB + hstepB, voffB); PG8_STAGE(PG8_SA(0, 0), cA, voffA); PG8_STAGE(PG8_SA(0, 1), cA + hstepA, voffA);
        if (wr == 1) PG8_BAR;
        PG8_WAIT_V(2); PG8_BAR;
        PG8_STAGE(PG8_SB(1, 0), cB + kstep, voffB); PG8_STAGE(PG8_SA(1, 0), cA + kstep, voffA); PG8_STAGE(PG8_SB(1, 1), cB + hstepB + kstep, voffB);
        PG8_WAIT_V(6); PG8_BAR;
    } else {
        PG8_STAGE(PG8_SB(0, 0), cB, voffB); PG8_STAGE(PG8_SA(0, 0), cA, voffA); PG8_STAGE(PG8_SB(0, 1), cB + hstepB, voffB); PG8_STAGE(PG8_SA(0, 1), cA + hstepA, voffA);
        if (wr == 1) PG8_BAR;
        PG8_WAIT_V(4); PG8_BAR;
        PG8_STAGE(PG8_SB(1, 0), cB + kstep, voffB); PG8_STAGE(PG8_SA(1, 0), cA + kstep, voffA); PG8_STAGE(PG8_SB(1, 1), cB + hstepB + kstep, voffB);
        PG8_WAIT_V(6); PG8_BAR;
    }
    for (;;) {
        const bool has_next = S.next(ui + 1, nxt);
        const char* nA = has_next ? (const char*)g.A + (size_t)nxt.pm * tstepA : cA; const char* nB = has_next ? (const char*)g.Bt + (size_t)nxt.pn * tstepB : cB;
#pragma clang loop unroll(disable)
        for (int t = 0; t < nt; t += 2) {
            if constexpr (HOOK_T >= 0) { if (t == HOOK_T) { if constexpr (FP8) asm volatile("s_nop 15\n\ts_nop 7" ::: "memory"); E.mid(acc, cur, wr, wc, fr, fq); } }
            const bool last = (t == nt - 2);
            const char* a1 = cA + (size_t)(t + 1) * kstep;
            const char* a2 = last ? nA : cA + (size_t)(t + 2) * kstep; const char* b2 = last ? nB : cB + (size_t)(t + 2) * kstep;
            const char* a3 = a2 + kstep; const char* b3 = b2 + kstep;
            if (last && has_next) S.a_ready(nxt);
            if constexpr (SP2) {
            PG8_LDB(B0, 0, 0); PG8_LDB(B1, 0, 1); PG8_SCHED; PG8_LDA(At, 0, 0); PG8_STAGE(PG8_SA(1, 1), a1 + hstepA, voffA);
            PG8_WAIT_V(8); PG8_WAIT_L(0); PG8_BAR; PG8_MMA(0, 0, At, B0); PG8_MMA(0, 1, At, B1); PG8_BAR; PG8_SCHED;
            PG8_LDA(At, 0, 1); PG8_STAGE(PG8_SB(0, 0), b2, voffB); PG8_STAGE(PG8_SB(0, 1), b2 + hstepB, voffB); PG8_STAGE(PG8_SA(0, 0), a2, voffA);
            PG8_WAIT_V(8); PG8_WAIT_L(0); PG8_BAR; PG8_MMA(1, 0, At, B0); PG8_MMA(1, 1, At, B1); PG8_BAR; PG8_SCHED;
            PG8_LDB(B0, 1, 0); PG8_LDB(B1, 1, 1); PG8_SCHED; PG8_LDA(At, 1, 0); PG8_STAGE(PG8_SA(0, 1), a2 + hstepA, voffA);
            PG8_WAIT_V(8); PG8_WAIT_L(0); PG8_BAR; PG8_MMA(0, 0, At, B0); PG8_MMA(0, 1, At, B1); PG8_BAR; PG8_SCHED;
            PG8_LDA(At, 1, 1); PG8_STAGE(PG8_SB(1, 0), b3, voffB); PG8_STAGE(PG8_SB(1, 1), b3 + hstepB, voffB); PG8_STAGE(PG8_SA(1, 0), a3, voffA);
            PG8_WAIT_V(8); PG8_WAIT_L(0); PG8_BAR; PG8_MMA(1, 0, At, B0); PG8_MMA(1, 1, At, B1); PG8_BAR; PG8_SCHED;
            } else {
            PG8_LDB(B0, 0, 0); PG8_SCHED; PG8_LDA(At, 0, 0); PG8_STAGE(PG8_SA(1, 1), a1 + hstepA, voffA);
            PG8_WAIT_L(8); PG8_BAR; PG8_WAIT_L(0); PG8_MMA(0, 0, At, B0); PG8_BAR; PG8_SCHED;
            PG8_LDB(B1, 0, 1); PG8_STAGE(PG8_SB(0, 0), b2, voffB);
            PG8_BAR; PG8_WAIT_L(0); PG8_MMA(0, 1, At, B1); PG8_BAR;
            PG8_LDA(At, 0, 1); PG8_STAGE(PG8_SA(0, 0), a2, voffA);
            PG8_BAR; PG8_WAIT_L(0); PG8_MMA(1, 0, At, B0); PG8_BAR; PG8_SCHED;
            PG8_STAGE(PG8_SB(0, 1), b2 + hstepB, voffB);
            PG8_WAIT_V(6); PG8_BAR; PG8_MMA(1, 1, At, B1); PG8_BAR;
            PG8_LDB(B0, 1, 0); PG8_SCHED; PG8_LDA(At, 1, 0); PG8_STAGE(PG8_SA(0, 1), a2 + hstepA, voffA);
            PG8_WAIT_L(8); PG8_BAR; PG8_WAIT_L(0); PG8_MMA(0, 0, At, B0); PG8_BAR; PG8_SCHED;
            PG8_LDB(B1, 1, 1); PG8_STAGE(PG8_SB(1, 0), b3, voffB);
            PG8_BAR; PG8_WAIT_L(0); PG8_MMA(0, 1, At, B1); PG8_BAR;
            PG8_LDA(At, 1, 1); PG8_STAGE(PG8_SA(1, 0), a3, voffA);
            PG8_BAR; PG8_WAIT_L(0); PG8_MMA(1, 0, At, B0); PG8_BAR; PG8_SCHED;
            PG8_STAGE(PG8_SB(1, 1), b3 + hstepB, voffB);
            PG8_WAIT_V(6); PG8_BAR; PG8_MMA(1, 1, At, B1); PG8_BAR;
            }
        }
        if constexpr (ALIGN_EPI) { if (wr == 0) PG8_BAR; }
        if constexpr (FP8) asm volatile("s_nop 15\n\ts_nop 7" ::: "memory");
        if constexpr (!Epi::AFTER_DRAIN) { E(acc, cur, wr, wc, fr, fq); S.done(cur); }
        if (!has_next) break;
#pragma unroll
        for (int a = 0; a < 2; ++a)
#pragma unroll
            for (int b = 0; b < 2; ++b)
#pragma unroll
                for (int m = 0; m < 4; ++m)
#pragma unroll
                    for (int n = 0; n < 2; ++n) acc[a][b][m][n] = (f32x4){0.f, 0.f, 0.f, 0.f};
        cur = nxt; cA = nA; cB = nB; ++ui;
        if constexpr (ALIGN_EPI) { if (wr == 1) PG8_BAR; }
    }
    PG8_WAIT_V(0);
    if constexpr (!ALIGN_EPI) { if (wr == 0) PG8_BAR; }
    PG8_BAR;
    if constexpr (Epi::AFTER_DRAIN) { E.fused(acc, cur, wr, wc, fr, fq, lds, wid, lane); S.done(cur); }
#undef PG8_SA
#undef PG8_SB
#undef PG8_STAGE
#undef PG8_LDA
#undef PG8_LDB
#undef PG8_MMA
#undef PG8_WAIT_V
#undef PG8_WAIT_L
#undef PG8_BAR
#undef PG8_SCHED
}
}

using namespace pg8;
#define LAS __attribute__((address_space(3)))
typedef float f32x16 __attribute__((ext_vector_type(16)));
typedef short s16x4 __attribute__((ext_vector_type(4)));
typedef short v4i16_t __attribute__((ext_vector_type(4)));

constexpr size_t MiB = 1u << 20;
constexpr size_t WS_SS1 = 0, WS_SS2 = 512 * 1024, WS_NORMT = 960 * 1024, WS_BAR = 992 * 1024;
constexpr size_t WS_ROPE = 1 * MiB;
constexpr size_t WS_LB = 5 * MiB;
constexpr size_t WS_WIN = 10 * MiB, WS_WBR = 20 * MiB, WS_WOUT = 22 * MiB, WS_WGU = 24 * MiB, WS_WD = 35 * MiB;
constexpr size_t WS_QKV = 42 * MiB;
constexpr size_t WS_G = 618 * MiB;
constexpr size_t WS_END = 1002 * MiB;
constexpr size_t WS_X1B = WS_QKV, WS_ACT = WS_QKV + 192 * MiB;
static_assert(WS_ACT + (size_t)T_ALL * DFF * 2 <= WS_END, "ws map");

constexpr int LDS_BYTES = 147456;
constexpr int AT_K = 0, AT_V = 49152, AT_WS = 98304, AT_OST = 100352;

__device__ __forceinline__ float wave_sum(float v) {
#pragma unroll
    for (int o = 1; o < 64; o <<= 1) v += __shfl_xor(v, o);
    return v;
}
__device__ __forceinline__ float wave_max(float v) {
#pragma unroll
    for (int o = 1; o < 64; o <<= 1) v = fmaxf(v, __shfl_xor(v, o));
    return v;
}

template <bool F8 = false>
__device__ __forceinline__ void transpose_item(const float* W, int N, bf16_t* WT, int ldw, int kcol, const float* kscale, int mode, LAS float* scr, int item, int lane, float mul = 1.0f) {
    const int nblk = N / 32, kb = item / nblk, nb = item % nblk, k0 = 64 * kb, n0 = 32 * nb;
    float wv[32], ks[32];
#pragma unroll
    for (int i = 0; i < 32; ++i) { const int kk = 2 * i + (lane >> 5); wv[i] = W[(size_t)(k0 + kk) * N + n0 + (lane & 31)]; ks[i] = kscale ? kscale[k0 + kk] : 1.0f; }
#pragma unroll
    for (int i = 0; i < 32; ++i) { const int kk = 2 * i + (lane >> 5); scr[kk * 33 + (lane & 31)] = wv[i] * ks[i] * mul; }
    asm volatile("s_waitcnt lgkmcnt(0)" ::: "memory");
    int rb;
    if (mode == 1) { if (n0 < NQKV) { const int np = n0 & 255; rb = (n0 & ~255) + 128 * ((np >> 5) & 1) + 32 * (np >> 6); }
                     else { const int c = n0 - NQKV, cc = c & 1023; rb = NQKV + (cc >> 7) * 256 + (c >> 10) * 128 + (cc & 127); } }
    else if (mode == 2) rb = (n0 >> 7) * 256 + (n0 & 127);
    else if (mode == 3) rb = (n0 >> 7) * 256 + 128 + (n0 & 127);
    else rb = n0;
    const int c = lane & 7;
#pragma unroll
    for (int j = 0; j < 4; ++j) { const int n = (lane >> 3) + 8 * j; const LAS float* s = scr + (8 * c) * 33 + n;
        if constexpr (F8) { u32x2 o; o.x = cvt_pk_fp8x4(s[0 * 33], s[1 * 33], s[2 * 33], s[3 * 33]); o.y = cvt_pk_fp8x4(s[4 * 33], s[5 * 33], s[6 * 33], s[7 * 33]);
            *(u32x2*)((unsigned char*)WT + (size_t)(rb + n) * ldw + kcol + k0 + 8 * c) = o; }
        else { u32x4 o; o.x = cvt_pk_bf16(s[0 * 33], s[1 * 33]); o.y = cvt_pk_bf16(s[2 * 33], s[3 * 33]); o.z = cvt_pk_bf16(s[4 * 33], s[5 * 33]); o.w = cvt_pk_bf16(s[6 * 33], s[7 * 33]);
            *(u32x4*)(WT + (size_t)(rb + n) * ldw + kcol + k0 + 8 * c) = o; } }
    asm volatile("s_waitcnt lgkmcnt(0)" ::: "memory");
}

#define XB_TMO      128
#define XB_XCNT(j)  (256  + 64 * (j))
#define XB_XSUB(j)  (1280 + 64 * (j))
#define XB_XGEN(j)  (2304 + 64 * (j))
#define XB_TOP      3328
#define XB_TOPGEN   3392
#define XCD_BAR_WORDS 3456
#define XB_SPIN_CAP (1u << 18)

__device__ __forceinline__ unsigned xb_ld(unsigned* p)              { return __hip_atomic_load(p, __ATOMIC_RELAXED, __HIP_MEMORY_SCOPE_AGENT); }
__device__ __forceinline__ unsigned xb_add(unsigned* p, unsigned v) { return __hip_atomic_fetch_add(p, v, __ATOMIC_RELAXED, __HIP_MEMORY_SCOPE_AGENT); }
__device__ __forceinline__ unsigned xb_xcc_id() { return (unsigned)__builtin_amdgcn_s_getreg((3 << 11) | 20) & 0xFu; }
#define XB_SPIN(cond, bar) do { unsigned _sp = 0; while (cond) { __builtin_amdgcn_s_sleep(1); \
    if ((++_sp & 255u) == 0u) { if (xb_ld(&(bar)[XB_TMO])) break; if (_sp > XB_SPIN_CAP) { atomicAdd(&(bar)[XB_TMO], 1u); break; } } } } while (0)

struct XcdBarrier {
    unsigned* bar; unsigned x;
    volatile LAS unsigned* st;
};

__device__ __forceinline__ XcdBarrier xcd_barrier_post(unsigned* bar, volatile LAS unsigned* st, bool leader) {
    XcdBarrier b; b.bar = bar; b.x = xb_xcc_id(); b.st = st;
    if (leader) (void)xb_add(&bar[XB_XCNT(b.x)], 1u);
    return b;
}
__device__ __forceinline__ void xcd_barrier_complete(unsigned* bar, unsigned x, unsigned& nloc, unsigned& nx) {
    const unsigned G = gridDim.x * gridDim.y * gridDim.z;
    unsigned sum, cnt, mine, sp = 0u;
    for (;;) {
        sum = 0u; cnt = 0u; mine = 0u;
#pragma unroll
        for (unsigned j = 0; j < 16; ++j) { const unsigned c = xb_ld(&bar[XB_XCNT(j)]); sum += c; cnt += (c > 0u) ? 1u : 0u; mine = (j == x) ? c : mine; }
        if (sum == G) break;
        __builtin_amdgcn_s_sleep(1);
        if ((++sp & 255u) == 0u) { if (xb_ld(&bar[XB_TMO])) break; if (sp > XB_SPIN_CAP) { atomicAdd(&bar[XB_TMO], 1u); break; } }
    }
    nloc = mine > 0u ? mine : 1u; nx = cnt > 0u ? cnt : 1u;
}

__device__ __forceinline__ void xcd_barrier(const XcdBarrier& b, bool leader) {
    asm volatile("s_waitcnt vmcnt(0)" ::: "memory");
    __syncthreads();
    if (leader) {
        unsigned* bar = b.bar;
        __builtin_amdgcn_s_waitcnt(0);
        unsigned nloc = b.st[0], nx = b.st[1];
        if (nloc == 0u) { xcd_barrier_complete(bar, b.x, nloc, nx); b.st[0] = nloc; b.st[1] = nx; }
        const unsigned old = xb_add(&bar[XB_XSUB(b.x)], 1u);
        const unsigned gen = old / nloc;
        if (old + 1u == (gen + 1u) * nloc) {
            __builtin_amdgcn_fence(__ATOMIC_RELEASE, "agent");
            asm volatile("s_waitcnt vmcnt(0)" ::: "memory");
            const unsigned og = xb_add(&bar[XB_TOP], 1u);
            const unsigned tg = og / nx;
            if (og + 1u == (tg + 1u) * nx) xb_add(&bar[XB_TOPGEN], 1u);
            else XB_SPIN(xb_ld(&bar[XB_TOPGEN]) == tg, bar);
            __builtin_amdgcn_fence(__ATOMIC_ACQUIRE, "agent");
            xb_add(&bar[XB_XGEN(b.x)], 1u);
            asm volatile("s_waitcnt vmcnt(0)" ::: "memory");
        } else {
            XB_SPIN(xb_ld(&bar[XB_XGEN(b.x)]) == gen, bar);
            __builtin_amdgcn_fence(__ATOMIC_ACQUIRE, "agent");
            asm volatile("s_waitcnt vmcnt(0)" ::: "memory");
        }
    }
    __syncthreads();
}


struct Args {
    const float *x_prompt, *x_sample, *norm1, *w_in, *qn_a, *kn_a, *sink_a, *qn_b, *kn_b, *w_br_a, *w_br_b, *w_out, *norm2, *w_gate, *w_up, *w_down;
    float* out; unsigned char* ws;
    float inv_freq[32];
    int ph_lo, ph_hi;
};

__device__ __forceinline__ void p0_prologue(const Args& a, LAS unsigned char* lds, int vcu, int G, const int wave) {
    int lane = lane_id(); asm volatile("" : "+v"(lane));
    unsigned char* ws = a.ws;
    const int gtid = vcu * 512 + wave * 64 + lane, NT = G * 512;
    float* ss1 = (float*)(ws + WS_SS1); float* ss2 = (float*)(ws + WS_SS2);
    for (int i = gtid; i < T_ALL; i += NT) ss2[i] = 0.f;
    if (gtid < 256) { const int w = gtid >> 6, c = gtid & 63; ((float*)(ws + WS_NORMT))[gtid] = (w == 0) ? a.qn_a[c] : (w == 1) ? a.kn_a[c] : (w == 2) ? a.qn_b[c] : a.kn_b[c]; }
    f32x2* rope = (f32x2*)(ws + WS_ROPE);
    for (int i = gtid; i < 16384 * 32; i += NT) { const int pos = i >> 5, c = i & 31; const float ang = (float)pos * a.inv_freq[c];
        double rev = (double)ang * 0.15915494309189535; rev -= floor(rev); const float fr = (float)rev;
        rope[i] = (f32x2){__builtin_amdgcn_cosf(fr), __builtin_amdgcn_sinf(fr)}; }
    LAS float* scr = (LAS float*)(lds + wave * 16384);
    const int gw = vcu * 8 + wave, NGW = G * 8;
    constexpr int I_IN = (DM / 64) * (NIN / 32), I_BA = (512 / 64) * (DM / 32), I_BB = (256 / 64) * (DM / 32), I_OUT = (DM / 64) * (DM / 32), I_G = (DM / 64) * (DFF / 32), I_D = (DFF / 64) * (DM / 32);
    constexpr int NITEMS = I_IN + I_BA + I_BB + I_OUT + 2 * I_G + I_D;
    bf16_t* WinT = (bf16_t*)(ws + WS_WIN); bf16_t* WbrT = (bf16_t*)(ws + WS_WBR); bf16_t* WoutT = (bf16_t*)(ws + WS_WOUT); bf16_t* WguT = (bf16_t*)(ws + WS_WGU); bf16_t* WdT = (bf16_t*)(ws + WS_WD);
    for (int it = gw; it < NITEMS; it += NGW) {
        int r = it;
        if (r < I_IN) { transpose_item<true>(a.w_in, NIN, WinT, DM, 0, a.norm1, 1, scr, r, lane, W8_SCALE); continue; } r -= I_IN;
        if (r < I_BA) { transpose_item<true>(a.w_br_a, DM, WbrT, KBR, 0, nullptr, 0, scr, r, lane, WBR8_SCALE); continue; } r -= I_BA;
        if (r < I_BB) { transpose_item<true>(a.w_br_b, DM, WbrT, KBR, 512, nullptr, 0, scr, r, lane, WBR8_SCALE); continue; } r -= I_BB;
        if (r < I_OUT) { transpose_item<true>(a.w_out, DM, WoutT, DM, 0, nullptr, 0, scr, r, lane, W8_SCALE); continue; } r -= I_OUT;
        if (r < I_G) { transpose_item(a.w_gate, DFF, WguT, DM, 0, a.norm2, 2, scr, r, lane); continue; } r -= I_G;
        if (r < I_G) { transpose_item(a.w_up, DFF, WguT, DM, 0, a.norm2, 3, scr, r, lane); continue; } r -= I_G;
        transpose_item(a.w_down, DM, WdT, DFF, 0, nullptr, 0, scr, r, lane);
    }
    bf16_t* XB = (bf16_t*)a.out;
    for (int m0 = gw; m0 < T_ALL; m0 += 4 * NGW) {
        f32x4 v[4][4]; float s[4] = {0.f, 0.f, 0.f, 0.f};
#pragma unroll
        for (int k = 0; k < 4; ++k) { const int m = (m0 + k * NGW < T_ALL) ? m0 + k * NGW : m0;
            const float* xrow = (m < T_P) ? a.x_prompt + (size_t)m * DM : a.x_sample + (size_t)(m - T_P) * DM; const f32x4* xr = (const f32x4*)xrow + lane;
#pragma unroll
            for (int j = 0; j < 4; ++j) v[k][j] = __builtin_nontemporal_load(&xr[64 * j]); }
#pragma unroll
        for (int k = 0; k < 4; ++k)
#pragma unroll
            for (int j = 0; j < 4; ++j) s[k] += (v[k][j][0] * v[k][j][0] + v[k][j][1] * v[k][j][1]) + (v[k][j][2] * v[k][j][2] + v[k][j][3] * v[k][j][3]);
#pragma unroll
        for (int k = 0; k < 4; ++k) s[k] = wave_sum(s[k]);
#pragma unroll
        for (int k = 0; k < 4; ++k) { const int m = m0 + k * NGW; if (m >= T_ALL) break;
            unsigned* o4 = (unsigned*)((unsigned char*)XB + (size_t)m * DM) + lane;
#pragma unroll
            for (int j = 0; j < 4; ++j) o4[64 * j] = cvt_pk_fp8x4(v[k][j][0] * X8_SCALE, v[k][j][1] * X8_SCALE, v[k][j][2] * X8_SCALE, v[k][j][3] * X8_SCALE);
            if (lane == 0) ss1[m] = s[k]; }
    }
}

__device__ __forceinline__ int crow(int r, int hi) { return (r & 3) + 8 * (r >> 2) + 4 * hi; }
struct AUnit { size_t row0, qb, kb, vb; int dstr, res, Lf, ocol, jq0, jk0, t_lo, lbcol, slot0; float sink2; };

template <int NTL> __device__ __forceinline__ void at_issue(const bf16_t* QKV, const AUnit& u, int tid, u32x4 (&kreg)[NTL], u32x4 (&vreg)[NTL], bf16x8 (&qr)[4]) {
    const int row = tid >> 3, c = tid & 7, lane = tid & 63, r32 = lane & 31, hi = lane >> 5;
#pragma unroll
    for (int t = 0; t < NTL; ++t) { int j = u.jk0 + 64 * t + row; j = j < 0 ? 0 : (j >= u.Lf ? u.Lf - 1 : j); const size_t off = (size_t)j * 64 + c * 8;
        kreg[t] = *(const u32x4*)(QKV + u.kb + off); vreg[t] = *(const u32x4*)(QKV + u.vb + off); }
    const bf16_t* qp = QKV + u.qb + (size_t)(u.jq0 + r32) * 64 + hi * 8;
#pragma unroll
    for (int d0 = 0; d0 < 4; ++d0) qr[d0] = *(const bf16x8*)(qp + d0 * 16);
}
template <int NTL> __device__ __forceinline__ void at_stage(LAS unsigned char* lds, int tid, const u32x4 (&kreg)[NTL], const u32x4 (&vreg)[NTL]) {
    const int row = tid >> 3, c = tid & 7;
    LAS unsigned char* kd = lds + AT_K + c * 1024 + ((row & ~7) | ((row ^ c) & 7)) * 16;
    LAS unsigned char* vd = lds + AT_V + ((c >> 2) * 4 + (row >> 4)) * 1024 + (row & 15) * 64 + (c & 3) * 16;
#pragma unroll
    for (int t = 0; t < NTL; ++t) { *(LAS u32x4*)(kd + t * 8192) = kreg[t]; *(LAS u32x4*)(vd + t * 8192) = vreg[t]; }
}
template <int MODE> __device__ __forceinline__ void at_softmax(f32x16& p0, f32x16& p1, float& lsum, u32x4 (&pw)[4], int dW, int kb, unsigned W2, unsigned Lf) {
#pragma unroll
    for (int r = 0; r < 16; ++r) { const int c0 = (r & 3) + 8 * (r >> 2);
        float e0 = __builtin_amdgcn_exp2f(p0[r]), e1 = __builtin_amdgcn_exp2f(p1[r]);
        if (MODE >= 1) { bool v0 = (unsigned)(dW + c0) <= W2, v1 = (unsigned)(dW + c0 + 32) <= W2;
            if (MODE == 2) { v0 = v0 && ((unsigned)(kb + c0) < Lf); v1 = v1 && ((unsigned)(kb + c0 + 32) < Lf); }
            e0 = v0 ? e0 : 0.f; e1 = v1 ? e1 : 0.f; }
        p0[r] = e0; p1[r] = e1; lsum += e0 + e1; }
#pragma unroll
    for (int i = 0; i < 4; ++i) { pw[0][i] = cvt_pk_bf16(p0[2 * i], p0[2 * i + 1]); pw[1][i] = cvt_pk_bf16(p0[8 + 2 * i], p0[9 + 2 * i]); pw[2][i] = cvt_pk_bf16(p1[2 * i], p1[2 * i + 1]); pw[3][i] = cvt_pk_bf16(p1[8 + 2 * i], p1[9 + 2 * i]); }
}
#define AT_SBAR() __builtin_amdgcn_sched_barrier(0)
#define AT_LOADK(sl_) do { const LAS unsigned char* kp_ = kp0 + (sl_) * 8192; _Pragma("unroll") for (int d0 = 0; d0 < 4; ++d0) { kf[2 * d0] = *(const LAS bf16x8*)(kp_ + koff[d0]); kf[2 * d0 + 1] = *(const LAS bf16x8*)(kp_ + koff[d0] + 512); } } while (0)
template <int NTW, bool IS_A>
__device__ __forceinline__ void at_compute(LAS unsigned char* lds, bf16_t* OUT, float* LB, const AUnit& u, const bf16x8 (&qr)[4], int W, int lane, int wave) {
    const int r32 = lane & 31, hi = lane >> 5;
    f32x16 o[2], zero; float lsum = 0.f;
#pragma unroll
    for (int r = 0; r < 16; ++r) { o[0][r] = 0.f; o[1][r] = 0.f; zero[r] = 0.f; }
    const int qj = u.jq0 + r32;
    const LAS unsigned char* kp0 = lds + AT_K;
    int koff[4];
#pragma unroll
    for (int d0 = 0; d0 < 4; ++d0) { const int ch = 2 * d0 + hi; koff[d0] = ch * 1024 + ((r32 & ~7) | ((r32 ^ ch) & 7)) * 16; }
    const LAS unsigned char* vp0 = lds + AT_V + ((lane >> 4) & 1) * 32 + (lane & 3) * 8 + (4 * hi + ((lane & 15) >> 2)) * 64;
#pragma unroll 1
    for (int tt = 0; tt < NTW; ++tt) { const int t = u.t_lo + tt; const int tlo = u.jk0 + 64 * t;
        const bool edge = IS_A ? (tt == 0 || tt == NTW - 1) : (tt != 1);
        const bool inside = (tlo >= 0) && (tlo + 64 <= u.Lf);
        const int kb = tlo + 4 * hi, dW = kb - qj + W;
        int sl = u.slot0 + t; sl = sl >= 6 ? sl - 6 : sl;
        const LAS unsigned char* vp = vp0 + sl * 8192;
        bf16x8 kf[8]; AT_LOADK(sl);
        s16x4 vlo[4], vhi[4], wlo[4], whi[4];
#pragma unroll
        for (int i = 0; i < 4; ++i) { vlo[i] = __builtin_bit_cast(s16x4, __builtin_amdgcn_ds_read_tr16_b64_v4i16((LAS v4i16_t*)(vp + i * 1024)));
            vhi[i] = __builtin_bit_cast(s16x4, __builtin_amdgcn_ds_read_tr16_b64_v4i16((LAS v4i16_t*)(vp + i * 1024 + 512))); }
        AT_SBAR();
        f32x16 p0 = __builtin_amdgcn_mfma_f32_32x32x16_bf16(kf[0], qr[0], zero, 0, 0, 0), p1 = __builtin_amdgcn_mfma_f32_32x32x16_bf16(kf[1], qr[0], zero, 0, 0, 0);
#pragma unroll
        for (int d0 = 1; d0 < 4; ++d0) { p0 = __builtin_amdgcn_mfma_f32_32x32x16_bf16(kf[2 * d0], qr[d0], p0, 0, 0, 0); p1 = __builtin_amdgcn_mfma_f32_32x32x16_bf16(kf[2 * d0 + 1], qr[d0], p1, 0, 0, 0); }
        AT_SBAR();
        u32x4 pw[4];
        if (!inside) at_softmax<2>(p0, p1, lsum, pw, dW, kb, (unsigned)(2 * W), (unsigned)u.Lf);
        else if (edge) at_softmax<1>(p0, p1, lsum, pw, dW, kb, (unsigned)(2 * W), (unsigned)u.Lf);
        else at_softmax<0>(p0, p1, lsum, pw, dW, kb, (unsigned)(2 * W), (unsigned)u.Lf);
#pragma unroll
        for (int i = 0; i < 4; ++i) { wlo[i] = __builtin_bit_cast(s16x4, __builtin_amdgcn_ds_read_tr16_b64_v4i16((LAS v4i16_t*)(vp + 4096 + i * 1024)));
            whi[i] = __builtin_bit_cast(s16x4, __builtin_amdgcn_ds_read_tr16_b64_v4i16((LAS v4i16_t*)(vp + 4096 + i * 1024 + 512))); }
        AT_SBAR();
#pragma unroll
        for (int ks = 0; ks < 4; ++ks) { const bf16x8 vf = (bf16x8){vlo[ks][0], vlo[ks][1], vlo[ks][2], vlo[ks][3], vhi[ks][0], vhi[ks][1], vhi[ks][2], vhi[ks][3]};
            o[0] = __builtin_amdgcn_mfma_f32_32x32x16_bf16(__builtin_bit_cast(bf16x8, pw[ks]), vf, o[0], 0, 0, 0); }
#pragma unroll
        for (int ks = 0; ks < 4; ++ks) { const bf16x8 vf = (bf16x8){wlo[ks][0], wlo[ks][1], wlo[ks][2], wlo[ks][3], whi[ks][0], whi[ks][1], whi[ks][2], whi[ks][3]};
            o[1] = __builtin_amdgcn_mfma_f32_32x32x16_bf16(__builtin_bit_cast(bf16x8, pw[ks]), vf, o[1], 0, 0, 0); }
    }
    lsum += __shfl_xor(lsum, 32);
    LAS float* wsf = (LAS float*)(lds + AT_WS) + wave * 64;
    LAS bf16_t* stg = (LAS bf16_t*)(lds + AT_OST) + wave * 2048;
    if (IS_A) { lsum += __builtin_amdgcn_exp2f(u.sink2); if (hi == 0) wsf[r32] = __builtin_amdgcn_rcpf(lsum) * AO8_SCALE; }
    else { if (hi == 0) LB[(u.row0 + (size_t)(u.jq0 + r32) * u.dstr + u.res) * 12 + u.lbcol] = lsum; }
    asm volatile("s_waitcnt lgkmcnt(0)" ::: "memory");
    if (IS_A) {
        LAS unsigned char* st8 = (LAS unsigned char*)stg;
#pragma unroll
        for (int r = 0; r < 16; ++r) { const int orow = crow(r, hi); const float sc = wsf[orow];
            const unsigned w = (unsigned)__builtin_amdgcn_cvt_pk_fp8_f32(o[0][r] * sc, o[1][r] * sc, 0, false);
            st8[orow * 64 + r32] = (unsigned char)(w & 0xffu); st8[orow * 64 + 32 + r32] = (unsigned char)((w >> 8) & 0xffu); }
        asm volatile("s_waitcnt lgkmcnt(0)" ::: "memory");
#pragma unroll
        for (int i = 0; i < 2; ++i) { const int row = i * 16 + (lane >> 2), ch = lane & 3; const u32x4 v = *(const LAS u32x4*)(st8 + row * 64 + ch * 16);
            *(u32x4*)((unsigned char*)OUT + (u.row0 + (size_t)(u.jq0 + row)) * KBR + u.ocol + ch * 16) = v; }
    } else {
#pragma unroll
        for (int r = 0; r < 16; ++r) { const int orow = crow(r, hi);
#pragma unroll
            for (int d0 = 0; d0 < 2; ++d0) { const unsigned w = cvt_pk_bf16(o[d0][r], 0.f); stg[orow * 64 + d0 * 32 + r32] = (bf16_t)(w & 0xffffu); } }
        asm volatile("s_waitcnt lgkmcnt(0)" ::: "memory");
#pragma unroll
        for (int i = 0; i < 4; ++i) { const int row = i * 8 + (lane >> 3), ch = lane & 7; const u32x4 v = *(const LAS u32x4*)(stg + row * 64 + ch * 8);
            *(u32x4*)(OUT + (u.row0 + (size_t)(u.jq0 + row) * u.dstr + u.res) * KBR + u.ocol + ch * 8) = v; }
    }
}

__device__ __forceinline__ AUnit unit_a(int u, int wave, const float* sink_a, float) {
    AUnit d; const int kvh = u / (T_ALL / 64), qt = u % (T_ALL / 64); const int tok0 = qt * 64; int L;
    d.slot0 = (qt + 4) % 6;
    if (tok0 < T_P) { d.row0 = (size_t)(tok0 & ~(L_P - 1)); L = L_P; } else { d.row0 = (size_t)(tok0 & ~(L_S - 1)); L = L_S; }
    const int q0 = tok0 - (int)d.row0, head = kvh * 4 + (wave >> 1);
    d.dstr = 1; d.res = 0; d.Lf = L; d.ocol = head * 64; d.qb = ((size_t)head * T_ALL + d.row0) * 64; d.kb = ((size_t)(8 + kvh) * T_ALL + d.row0) * 64; d.vb = ((size_t)(10 + kvh) * T_ALL + d.row0) * 64; d.jq0 = q0 + 32 * (wave & 1); d.jk0 = q0 - 128; d.t_lo = 0; d.lbcol = 0;
    d.sink2 = sink_a[head] * 1.4426950408889634f; return d;
}
__device__ __forceinline__ AUnit unit_b(int u, int wave) {
    constexpr int NSL = T_ALL / 256; AUnit d; const int hb = u / NSL, sl = u % NSL; const int g = hb >> 2; const int dl = (g == 0) ? 1 : (g == 1 ? 4 : 16);
    int L, e;
    if (sl < T_P / 256) { d.row0 = (size_t)(sl / (L_P / 256)) * L_P; e = sl % (L_P / 256); L = L_P; } else { const int s2 = sl - T_P / 256; d.row0 = (size_t)T_P + (size_t)(s2 / (L_S / 256)) * L_S; e = s2 % (L_S / 256); L = L_S; }
    const int fb = e / dl, j0 = fb * 256;
    d.dstr = dl; d.res = e % dl; d.Lf = L / dl; d.ocol = hb * 64; { const size_t f0 = d.row0 + (size_t)d.res * d.Lf; d.qb = ((size_t)(12 + hb) * T_ALL + f0) * 64; d.kb = ((size_t)(24 + hb) * T_ALL + f0) * 64; d.vb = ((size_t)(36 + hb) * T_ALL + f0) * 64; } d.jq0 = j0 + 32 * wave; d.jk0 = j0 - 64; d.t_lo = wave >> 1; d.lbcol = hb; d.slot0 = 0; d.sink2 = 0.f; return d;
}

__device__ __forceinline__ void attention_phase(const Args& a, LAS unsigned char* lds, int vcu, int G, const int wave) {
    int lane = lane_id(); asm volatile("" : "+v"(lane));
    const int tid = wave * 64 + lane;
    bf16_t* QKV = (bf16_t*)(a.ws + WS_QKV); float* LB = (float*)(a.ws + WS_LB);
    bf16_t* AO = (bf16_t*)a.out; bf16_t* OBG = AO + (size_t)T_ALL * KBR;
    constexpr int NUA = (T_ALL / 64) * 2;
    { const int per = (NUA + G - 1) / G; const int ub = vcu * per; int nall = NUA - ub; nall = nall < 0 ? 0 : (nall > per ? per : nall);
      const int runlen = ((T_ALL / 64) % per == 0) ? per : 1;
      for (int rs = 0; rs < nall; rs += runlen) { const int u0 = ub + rs; const int n = (nall - rs) < runlen ? (nall - rs) : runlen;
      const int row = tid >> 3, c = tid & 7;
      LAS unsigned char* kd = lds + AT_K + c * 1024 + ((row & ~7) | ((row ^ c) & 7)) * 16;
      LAS unsigned char* vd = lds + AT_V + ((c >> 2) * 4 + (row >> 4)) * 1024 + (row & 15) * 64 + (c & 3) * 16;
      if (n > 0) {
          const int kvh = u0 / (T_ALL / 64), g0 = u0 % (T_ALL / 64);
          const bf16_t* Kh = QKV + (size_t)(8 + kvh) * T_ALL * 64 + (size_t)row * 64 + c * 8; const bf16_t* Vh = QKV + (size_t)(10 + kvh) * T_ALL * 64 + (size_t)row * 64 + c * 8;
          u32x4 kn, vn; bf16x8 qn[4];
          { u32x4 k5[5], v5[5];
#pragma unroll
            for (int t = 0; t < 5; ++t) { int g = g0 - 2 + t; g = g < 0 ? 0 : (g > T_ALL / 64 - 1 ? T_ALL / 64 - 1 : g); k5[t] = *(const u32x4*)(Kh + (size_t)g * 4096); v5[t] = *(const u32x4*)(Vh + (size_t)g * 4096); }
            { const AUnit d = unit_a(u0, wave, a.sink_a, 0.f); const bf16_t* qp = QKV + d.qb + (size_t)(d.jq0 + (lane & 31)) * 64 + (lane >> 5) * 8;
#pragma unroll
              for (int d0 = 0; d0 < 4; ++d0) qn[d0] = *(const bf16x8*)(qp + d0 * 16); }
#pragma unroll
            for (int t = 0; t < 5; ++t) { const int sl = (g0 + 4 + t) % 6; *(LAS u32x4*)(kd + sl * 8192) = k5[t]; *(LAS u32x4*)(vd + sl * 8192) = v5[t]; } }
          for (int i = 0; i < n; ++i) { const AUnit d = unit_a(u0 + i, wave, a.sink_a, 0.f);
              if (i > 0) { const int sl = (g0 + i + 2) % 6; *(LAS u32x4*)(kd + sl * 8192) = kn; *(LAS u32x4*)(vd + sl * 8192) = vn; }
              bf16x8 qr[4] = {qn[0], qn[1], qn[2], qn[3]};
              __syncthreads();
              if (i + 1 < n) { int g = g0 + i + 3; g = g > T_ALL / 64 - 1 ? T_ALL / 64 - 1 : g; kn = *(const u32x4*)(Kh + (size_t)g * 4096); vn = *(const u32x4*)(Vh + (size_t)g * 4096);
                  const AUnit dn = unit_a(u0 + i + 1, wave, a.sink_a, 0.f); const bf16_t* qp = QKV + dn.qb + (size_t)(dn.jq0 + (lane & 31)) * 64 + (lane >> 5) * 8;
#pragma unroll
                  for (int d0 = 0; d0 < 4; ++d0) qn[d0] = *(const bf16x8*)(qp + d0 * 16); }
              at_compute<5, true>(lds, AO, LB, d, qr, 128, lane, wave);
              __syncthreads(); } } } }
    constexpr int NUB = 12 * (T_ALL / 256);
    { const int per = (NUB + G - 1) / G; const int u0 = vcu * per; int n = NUB - u0; n = n < 0 ? 0 : (n > per ? per : n);
      u32x4 kreg[6], vreg[6]; bf16x8 qn[4];
      if (n > 0) { const AUnit d = unit_b(u0, wave); at_issue<6>(QKV, d, tid, kreg, vreg, qn); }
      for (int i = 0; i < n; ++i) { const AUnit d = unit_b(u0 + i, wave);
          at_stage<6>(lds, tid, kreg, vreg); bf16x8 qr[4] = {qn[0], qn[1], qn[2], qn[3]};
          __syncthreads();
          if (i + 1 < n) { const AUnit dn = unit_b(u0 + i + 1, wave); at_issue<6>(QKV, dn, tid, kreg, vreg, qn); }
          at_compute<3, false>(lds, OBG, LB, d, qr, 64, lane, wave);
          __syncthreads(); } }
}

__device__ __forceinline__ void combine_phase(const Args& a, int vcu, int G, const int wave) {
    int tid = lane_id(); asm volatile("" : "+v"(tid)); tid += wave * 64;
    bf16_t* AO = (bf16_t*)a.out; const bf16_t* OBG = AO + (size_t)T_ALL * KBR; const float* LB = (const float*)(a.ws + WS_LB);
    const int NT = G * 512;
    for (int i0 = vcu * 512 + tid; i0 < T_ALL * 32; i0 += 4 * NT) {
        u32x4 v[4][3]; float lg[4][3];
#pragma unroll
        for (int k = 0; k < 4; ++k) { const int i = i0 + k * NT; const bool ok = i < T_ALL * 32; const size_t tok = (size_t)((ok ? i : i0) >> 5); const int hp = (i >> 3) & 3, ch = i & 7;
#pragma unroll
            for (int g = 0; g < 3; ++g) { lg[k][g] = LB[tok * 12 + 4 * g + hp]; v[k][g] = *(const u32x4*)(OBG + tok * KBR + (4 * g + hp) * 64 + ch * 8); } }
#pragma unroll
        for (int k = 0; k < 4; ++k) { const int i = i0 + k * NT; if (i >= T_ALL * 32) break; const size_t tok = (size_t)(i >> 5); const int hp = (i >> 3) & 3, ch = i & 7;
            const float rl = __builtin_amdgcn_rcpf(lg[k][0] + lg[k][1] + lg[k][2]) * AO8_SCALE; float o[8];
            o[0] = bf_lo(v[k][0].x) + bf_lo(v[k][1].x) + bf_lo(v[k][2].x); o[1] = bf_hi(v[k][0].x) + bf_hi(v[k][1].x) + bf_hi(v[k][2].x);
            o[2] = bf_lo(v[k][0].y) + bf_lo(v[k][1].y) + bf_lo(v[k][2].y); o[3] = bf_hi(v[k][0].y) + bf_hi(v[k][1].y) + bf_hi(v[k][2].y);
            o[4] = bf_lo(v[k][0].z) + bf_lo(v[k][1].z) + bf_lo(v[k][2].z); o[5] = bf_hi(v[k][0].z) + bf_hi(v[k][1].z) + bf_hi(v[k][2].z);
            o[6] = bf_lo(v[k][0].w) + bf_lo(v[k][1].w) + bf_lo(v[k][2].w); o[7] = bf_hi(v[k][0].w) + bf_hi(v[k][1].w) + bf_hi(v[k][2].w);
            u32x2 w; w.x = cvt_pk_fp8x4(o[0] * rl, o[1] * rl, o[2] * rl, o[3] * rl); w.y = cvt_pk_fp8x4(o[4] * rl, o[5] * rl, o[6] * rl, o[7] * rl);
            *(u32x2*)((unsigned char*)AO + tok * KBR + 512 + hp * 64 + ch * 8) = w; } }
}

constexpr int NPH = 8;
__global__ void __launch_bounds__(512, 2) fwd_megakernel(Args args) {
    extern __shared__ __attribute__((aligned(16))) unsigned char lds_raw[];
    LAS unsigned char* lds = (LAS unsigned char*)lds_raw;
    int wave_ = __builtin_amdgcn_readfirstlane(threadIdx.x >> 6); asm volatile("" : "+s"(wave_)); const int wave = wave_;
    const int G = gridDim.x, bx = blockIdx.x; const int vcu = (G % 8 == 0) ? (bx % 8) * (G / 8) + bx / 8 : bx;
    unsigned char* ws = args.ws;
    const int lo = args.ph_lo, hi = args.ph_hi;
#define IN(k) (lo <= (k) && (k) < hi)
    volatile LAS unsigned* bst = (volatile LAS unsigned*)(lds + LDS_BYTES - 64);
    { const bool leader0 = (wave == 0) && (lane_id() == 0); if (leader0) { bst[0] = 0u; bst[1] = 0u; } }
    __syncthreads();
    XcdBarrier xbar; xbar.bar = (unsigned*)(ws + WS_BAR); xbar.x = xb_xcc_id(); xbar.st = bst;
    if (bx == 0) { for (int i = wave * 64 + lane_id(); i < XCD_BAR_WORDS; i += 512) __hip_atomic_store(xbar.bar + i, 0u, __ATOMIC_RELAXED, __HIP_MEMORY_SCOPE_AGENT); }
#define SEAM(k) do { if (IN(k) && IN((k) + 1)) { if ((k) == 0) { cg::this_grid().sync(); if ((wave == 0) && (lane_id() == 0)) (void)xb_add(&xbar.bar[XB_XCNT(xbar.x)], 1u); } else xcd_barrier(xbar, (wave == 0) && (lane_id() == 0)); } } while (0)
    bf16_t* QKV = (bf16_t*)(ws + WS_QKV); bf16_t* Gt = (bf16_t*)(ws + WS_G);
    float* ss1 = (float*)(ws + WS_SS1); float* ss2 = (float*)(ws + WS_SS2);
    if (IN(0)) { p0_prologue(args, lds, vcu, G, wave); }
    SEAM(0);
    if (IN(1)) {
        Gemm g{(const bf16_t*)args.out, (const bf16_t*)(ws + WS_WIN), T_ALL, NIN, DM / 2, DM / 2, DM / 2}; InProjOrder S; S.init(T_ALL, NIN, G, bx);
        { LAS float* lt = (LAS float*)(lds + 131072); int l2 = lane_id(); asm volatile("" : "+v"(l2)); const int t2 = wave * 64 + l2;
          if (t2 < 256) lt[t2] = ((const float*)(ws + WS_NORMT))[t2] * (((t2 >> 6) & 1) ? 1.0f : QSCALE);
          else if (t2 < 320) lt[t2] = ((const float*)(ws + WS_ROPE))[16 * 64 + (t2 - 256)];
          __syncthreads(); }
        EpiInProj E{QKV, Gt, ss1, (const f32x2*)(ws + WS_ROPE), (const LAS float*)(lds + 131072), 1.0f / (X8_SCALE * W8_SCALE)};
        gemm_phase<EpiInProj, InProjOrder, true, true, -1, true>(lds, g, S, E, wave);
    }
    SEAM(1);
    if (IN(2)) { attention_phase(args, lds, vcu, G, wave); }
    SEAM(2);
    if (IN(3)) { combine_phase(args, vcu, G, wave); }
    SEAM(3);
    if (IN(4)) {
        Gemm g{(const bf16_t*)args.out, (const bf16_t*)(ws + WS_WBR), T_ALL, DM, KBR / 2, KBR / 2, KBR / 2};   StaticOrder S; S.init(T_ALL, DM, G, bx); EpiBranchFused E{Gt, ws + WS_ACT};
        gemm_phase<EpiBranchFused, StaticOrder, true, true, 4, true>(lds, g, S, E, wave);
    }
    SEAM(4);
    if (IN(5)) {
        Gemm g{(const bf16_t*)(ws + WS_ACT), (const bf16_t*)(ws + WS_WOUT), T_ALL, DM, DM / 2, DM / 2, DM / 2}; StaticOrder S; S.init(T_ALL, DM, G, bx);
        EpiOutProj E{args.x_prompt, args.x_sample, args.out, (bf16_t*)(ws + WS_X1B), ss2, 1.0f / (MIX8_SCALE * W8_SCALE)};
        gemm_phase<EpiOutProj, StaticOrder, true, true, -1, true>(lds, g, S, E, wave);
    }
    SEAM(5);
    if (IN(6)) {
        Gemm g{(const bf16_t*)(ws + WS_X1B), (const bf16_t*)(ws + WS_WGU), T_ALL, NGU, DM, DM, DM}; StaticOrder S; S.init(T_ALL, NGU, G, bx);
        EpiGateUp E{(bf16_t*)(ws + WS_ACT), ss2};
        gemm_phase<EpiGateUp, StaticOrder, true, true>(lds, g, S, E, wave);
    }
    SEAM(6);
    if (IN(7)) {
        Gemm g{(const bf16_t*)(ws + WS_ACT), (const bf16_t*)(ws + WS_WD), T_ALL, DM, DFF, DFF, DFF}; StaticOrder S; S.init(T_ALL, DM, G, bx);
        EpiDown E{args.out, (const bf16_t*)(ws + WS_X1B)};
        gemm_phase<EpiDown, StaticOrder, true, true>(lds, g, S, E, wave);
    }
#undef IN
#undef SEAM
}

#ifndef MK_N_LAUNCHES
#define MK_N_LAUNCHES 1
#endif

extern "C" void kernel_launch(void* const* d_in, const int* in_sizes, int n_in, void* d_out, int out_size, void* d_ws, size_t ws_size, hipStream_t stream) {
    static int grid = 0;
    if (grid == 0) {
        if (n_in != 16 || out_size != T_ALL * DM || ws_size < WS_END) { fprintf(stderr, "kernel_launch: unexpected shapes: n_in %d out %d ws %zu (need %zu)\n", n_in, out_size, ws_size, (size_t)WS_END); grid = -1; return; }
        int dev = 0, cus = 0, per_cu = 0;
        hipGetDevice(&dev); hipDeviceGetAttribute(&cus, hipDeviceAttributeMultiprocessorCount, dev);
        if (hipFuncSetAttribute((const void*)fwd_megakernel, hipFuncAttributeMaxDynamicSharedMemorySize, LDS_BYTES) != hipSuccess) { fprintf(stderr, "kernel_launch: hipFuncSetAttribute failed\n"); grid = -1; return; }
        if (hipOccupancyMaxActiveBlocksPerMultiprocessor(&per_cu, (const void*)fwd_megakernel, 512, LDS_BYTES) != hipSuccess || per_cu < 1) { fprintf(stderr, "kernel_launch: occupancy query says %d\n", per_cu); per_cu = 1; }
        (void)hipGetLastError();
        grid = cus * 1;
        fprintf(stderr, "kernel_launch: cus %d per_cu %d grid %d\n", cus, per_cu, grid);
    }
    if (grid < 0) return;
    Args a{};
    a.x_prompt = (const float*)d_in[0]; a.x_sample = (const float*)d_in[1]; a.norm1 = (const float*)d_in[2]; a.w_in = (const float*)d_in[3]; a.qn_a = (const float*)d_in[4]; a.kn_a = (const float*)d_in[5];
    a.sink_a = (const float*)d_in[6]; a.qn_b = (const float*)d_in[7]; a.kn_b = (const float*)d_in[8]; a.w_br_a = (const float*)d_in[9]; a.w_br_b = (const float*)d_in[10]; a.w_out = (const float*)d_in[11];
    a.norm2 = (const float*)d_in[12]; a.w_gate = (const float*)d_in[13]; a.w_up = (const float*)d_in[14]; a.w_down = (const float*)d_in[15];
    a.out = (float*)d_out; a.ws = (unsigned char*)d_ws;
    for (int c = 0; c < 32; ++c) a.inv_freq[c] = (float)pow(10000.0, -(double)c / 32.0);
#if MK_N_LAUNCHES == 1
    a.ph_lo = 0; a.ph_hi = NPH;
    void* kargs[] = {&a};
    hipError_t e = hipLaunchCooperativeKernel((const void*)fwd_megakernel, dim3(grid), dim3(512), kargs, LDS_BYTES, stream);
    if (e != hipSuccess) fprintf(stderr, "kernel_launch: cooperative launch failed: %s (grid %d)\n", hipGetErrorString(e), grid);
#else
    for (int p = 0; p < NPH; ++p) { a.ph_lo = p; a.ph_hi = p + 1; hipLaunchKernelGGL(fwd_megakernel, dim3(grid), dim3(512), LDS_BYTES, stream, a); }
#endif
}
```
